# Optimizing an MI355X kernel written in HIP

```python
import math
import jax, jax.numpy as jnp
from jax import lax
import numpy as np

D_MODEL = 1024
BATCH = 16
SEQ = 2048
DEPTH = 4

GRID_W = 64
CTX_LEN = 256
D_CHUNK = D_MODEL // 4
D_ATTN = D_MODEL // 2
D_LRU = D_MODEL // 4
D_MIX = D_CHUNK + D_ATTN + D_LRU
CHUNK = 128
A_GROUPS = 4
A_GDIM = D_CHUNK // A_GROUPS
HEAD_DIM = 64
N_HEADS = D_ATTN // HEAD_DIM
N_KV_HEADS = N_HEADS // 4
GQA_GROUP = N_HEADS // N_KV_HEADS
D_KV = N_KV_HEADS * HEAD_DIM
Q_BLOCK = 128
ROPE_THETA = 10000.0
LRU_BLOCKS = 4
LRU_BDIM = D_LRU // LRU_BLOCKS
CONV_W = 4
LRU_C = 8.0
N_DIR = 2
IN_SPLITS = (D_CHUNK, D_CHUNK, D_CHUNK,
             D_ATTN, D_KV, D_KV, D_ATTN,
             D_LRU, D_LRU)
IN_OFFSETS = tuple(int(s) for s in np.cumsum(IN_SPLITS)[:-1])
D_IN = int(sum(IN_SPLITS))
ALPHA = (2.0 * DEPTH) ** 0.25
BETA = (8.0 * DEPTH) ** -0.25
LN_EPS = 1e-6
RMS_EPS = 1e-6

kernel_name = "hybrid_parallel_groups_dit_block"


def layer_norm(x, g, b):
    xf = x.astype(jnp.float32)
    mu = jnp.mean(xf, -1, keepdims=True)
    var = jnp.mean(jnp.square(xf - mu), -1, keepdims=True)
    return ((xf - mu) * lax.rsqrt(var + LN_EPS) * g + b).astype(x.dtype)


def rms_norm(x, g):
    xf = x.astype(jnp.float32)
    ms = jnp.mean(jnp.square(xf), -1, keepdims=True)
    return (xf * lax.rsqrt(ms + RMS_EPS) * g).astype(x.dtype)


def axial_rope(x, rows, cols):
    half = HEAD_DIM // 2
    nf = half // 2
    inv = ROPE_THETA ** (-jnp.arange(nf, dtype=jnp.float32) / nf)

    def rot(xp, p):
        ang = p.astype(jnp.float32)[:, None] * inv
        cos = jnp.cos(ang)[None, :, None, :]
        sin = jnp.sin(ang)[None, :, None, :]
        x1 = xp[..., :nf].astype(jnp.float32)
        x2 = xp[..., nf:].astype(jnp.float32)
        return jnp.concatenate([x1 * cos - x2 * sin, x1 * sin + x2 * cos], -1)

    out = jnp.concatenate([rot(x[..., :half], rows), rot(x[..., half:], cols)], -1)
    return out.astype(x.dtype)


def chunk_gmlp(u, v, g, b, w_s, b_s):
    Bn, L, _ = u.shape
    u = jax.nn.gelu(u)
    v = layer_norm(jax.nn.gelu(v), g, b)
    v = v.reshape(Bn, L // CHUNK, CHUNK, A_GROUPS, A_GDIM)
    s = jnp.einsum('gpq,bnqgc->bnpgc', w_s, v) + b_s.T[:, :, None]
    return u * s.reshape(Bn, L, D_CHUNK)


def blocked_attention(q, k, v):
    Bn, L = q.shape[:2]
    nblk = L // Q_BLOCK
    qb = q.reshape(Bn, nblk, Q_BLOCK, N_KV_HEADS, GQA_GROUP, HEAD_DIM).transpose(1, 0, 2, 3, 4, 5)
    scale = HEAD_DIM ** -0.5

    def one_block(qblk):
        s = jnp.einsum('bqgrd,bkgd->bgrqk', qblk, k).astype(jnp.float32) * scale
        p = jax.nn.softmax(s, axis=-1).astype(v.dtype)
        return jnp.einsum('bgrqk,bkgd->bqgrd', p, v)

    o = lax.map(one_block, qb)
    return o.transpose(1, 0, 2, 3, 4, 5).reshape(Bn, L, D_ATTN)


def centred_dwconv(x, w, b):
    L = x.shape[1]
    left = CONV_W // 2
    xp = jnp.pad(x, ((0, 0), (left, CONV_W - 1 - left), (0, 0)))
    y = b
    for t in range(CONV_W):
        y = y + xp[:, t:t + L] * w[t]
    return y


def rglru_coeffs(x, w_r, b_r, w_i, b_i, lam):
    xb = x.reshape(*x.shape[:-1], LRU_BLOCKS, LRU_BDIM)
    r = jax.nn.sigmoid(jnp.einsum('blhi,hij->blhj', xb, w_r).reshape(x.shape) + b_r)
    i = jax.nn.sigmoid(jnp.einsum('blhi,hij->blhj', xb, w_i).reshape(x.shape) + b_i)
    log_a = -LRU_C * r.astype(jnp.float32) * jax.nn.softplus(-lam.astype(jnp.float32))
    a = jnp.exp(log_a)
    mult = jnp.sqrt(-jnp.expm1(2.0 * log_a))
    return a, mult * (i * x).astype(jnp.float32)


def linear_scan(a, bx, h0):
    bx = bx.at[:, 0].add(a[:, 0] * h0)

    def comb(l, r):
        return (l[0] * r[0], r[0] * l[1] + r[1])

    _, h = lax.associative_scan(comb, (a, bx), axis=1)
    return h


def rglru_direction(xl, xc, w_r, b_r, w_i, b_i, lam, reverse):
    a_c, b_c = rglru_coeffs(xc, w_r, b_r, w_i, b_i, lam)
    a_l, b_l = rglru_coeffs(xl, w_r, b_r, w_i, b_i, lam)
    if reverse:
        a_c, b_c, a_l, b_l = (jnp.flip(t, 1) for t in (a_c, b_c, a_l, b_l))
    h_c = linear_scan(a_c, b_c, jnp.zeros(a_c.shape[::2], jnp.float32))
    h_l = linear_scan(a_l, b_l, h_c[:, -1])
    if reverse:
        h_c, h_l = jnp.flip(h_c, 1), jnp.flip(h_l, 1)
    return h_l, h_c


def hybrid_layer(x, xc, c, c_ctx, rows, cols, w_ada, b_ada, w_in, a_norm_g, a_norm_b, a_ws, a_bs,
                 q_norm_g, k_norm_g, conv_w, conv_b, lru_wr, lru_br, lru_wi, lru_bi, lru_lam,
                 w_o, ln_g, ln_b, with_ctx_out):
    Bn, L, _ = x.shape
    Lc = xc.shape[1]
    shift, scale, gate = jnp.split(jax.nn.silu(c) @ w_ada + b_ada, 3, -1)
    shift_c, scale_c, gate_c = jnp.split(jax.nn.silu(c_ctx) @ w_ada + b_ada, 3, -1)
    z = (x * (1 + scale[:, None]) + shift[:, None]) @ w_in
    zc = (xc * (1 + scale_c) + shift_c) @ w_in
    a_u, a_v, a_g, q, k, v, b_g, r_x, r_g = jnp.split(z, IN_OFFSETS, -1)
    ac_u, ac_v, ac_g, qc, kc, vc, bc_g, rc_x, rc_g = jnp.split(zc, IN_OFFSETS, -1)

    q = axial_rope(rms_norm(q.reshape(Bn, L, N_HEADS, HEAD_DIM), q_norm_g), rows, cols)
    k = axial_rope(rms_norm(k.reshape(Bn, L, N_KV_HEADS, HEAD_DIM), k_norm_g), rows, cols)
    v = v.reshape(Bn, L, N_KV_HEADS, HEAD_DIM)
    kc = rms_norm(kc.reshape(Bn, Lc, N_KV_HEADS, HEAD_DIM), k_norm_g)
    vc = vc.reshape(Bn, Lc, N_KV_HEADS, HEAD_DIM)
    attn = blocked_attention(q, jnp.concatenate([k, kc], 1), jnp.concatenate([v, vc], 1))

    mix_a = chunk_gmlp(a_u, a_v, a_norm_g, a_norm_b, a_ws, a_bs)

    xr = centred_dwconv(r_x, conv_w, conv_b)
    xrc = centred_dwconv(rc_x, conv_w, conv_b)
    h_f, hc_f = rglru_direction(xr, xrc, lru_wr[0], lru_br[0], lru_wi[0], lru_bi[0], lru_lam[0], False)
    h_b, hc_b = rglru_direction(xr, xrc, lru_wr[1], lru_br[1], lru_wi[1], lru_bi[1], lru_lam[1], True)
    lru = (h_f + h_b).astype(x.dtype)

    y = jnp.concatenate([mix_a * jax.nn.silu(a_g), attn * jax.nn.silu(b_g),
                         lru * jax.nn.silu(r_g)], -1) @ w_o
    x_new = layer_norm(ALPHA * x + gate[:, None] * y, ln_g, ln_b)

    if not with_ctx_out:
        return x_new, xc
    qc = rms_norm(qc.reshape(Bn, Lc, N_HEADS, HEAD_DIM), q_norm_g)
    attn_c = blocked_attention(qc, kc, vc)
    mix_ac = chunk_gmlp(ac_u, ac_v, a_norm_g, a_norm_b, a_ws, a_bs)
    lru_c = (hc_f + hc_b).astype(xc.dtype)
    yc = jnp.concatenate([mix_ac * jax.nn.silu(ac_g), attn_c * jax.nn.silu(bc_g),
                          lru_c * jax.nn.silu(rc_g)], -1) @ w_o
    xc_new = layer_norm(ALPHA * xc + gate_c * yc, ln_g, ln_b)
    return x_new, xc_new


def setup_inputs(seed: int = 0) -> dict:
    key = jax.random.key(seed)
    ks = jax.random.split(key, 24)
    f32 = jnp.float32
    nrm = lambda k, shape, s: jax.random.normal(k, shape, f32) * s
    a0 = jax.random.uniform(ks[18], (DEPTH, N_DIR, D_LRU), f32, minval=0.9, maxval=0.999)
    return {
        "x": nrm(ks[0], (BATCH, SEQ, D_MODEL), 1.0),
        "c": nrm(ks[1], (BATCH, D_MODEL), 1.0),
        "ctx": nrm(ks[2], (BATCH, CTX_LEN, D_MODEL), 1.0),
        "c_ctx": nrm(ks[3], (D_MODEL,), 1.0),
        "w_ada": nrm(ks[4], (DEPTH, D_MODEL, 3 * D_MODEL), 0.5 * D_MODEL ** -0.5),
        "b_ada": nrm(ks[5], (DEPTH, 3 * D_MODEL), 0.01),
        "w_in": nrm(ks[6], (DEPTH, D_MODEL, D_IN), D_MODEL ** -0.5),
        "a_norm_g": 1.0 + nrm(ks[7], (DEPTH, D_CHUNK), 0.01),
        "a_norm_b": nrm(ks[8], (DEPTH, D_CHUNK), 0.01),
        "a_ws": nrm(ks[9], (DEPTH, A_GROUPS, CHUNK, CHUNK), CHUNK ** -0.5),
        "a_bs": 1.0 + nrm(ks[10], (DEPTH, A_GROUPS, CHUNK), 0.01),
        "q_norm_g": 1.0 + nrm(ks[11], (DEPTH, HEAD_DIM), 0.01),
        "k_norm_g": 1.0 + nrm(ks[12], (DEPTH, HEAD_DIM), 0.01),
        "conv_w": nrm(ks[13], (DEPTH, CONV_W, D_LRU), CONV_W ** -0.5),
        "conv_b": nrm(ks[14], (DEPTH, D_LRU), 0.01),
        "lru_wr": nrm(ks[15], (DEPTH, N_DIR, LRU_BLOCKS, LRU_BDIM, LRU_BDIM), LRU_BDIM ** -0.5),
        "lru_br": nrm(ks[16], (DEPTH, N_DIR, D_LRU), 0.01),
        "lru_wi": nrm(ks[17], (DEPTH, N_DIR, LRU_BLOCKS, LRU_BDIM, LRU_BDIM), LRU_BDIM ** -0.5),
        "lru_bi": nrm(ks[19], (DEPTH, N_DIR, D_LRU), 0.01),
        "lru_lam": jnp.log(a0) - jnp.log1p(-a0),
        "w_o": nrm(ks[20], (DEPTH, D_MIX, D_MODEL), BETA * D_MIX ** -0.5),
        "ln_g": 1.0 + nrm(ks[21], (DEPTH, D_MODEL), 0.01),
        "ln_b": nrm(ks[22], (DEPTH, D_MODEL), 0.01),
    }


def reference(x, c, ctx, c_ctx, w_ada, b_ada, w_in, a_norm_g, a_norm_b, a_ws, a_bs, q_norm_g,
              k_norm_g, conv_w, conv_b, lru_wr, lru_br, lru_wi, lru_bi, lru_lam, w_o, ln_g, ln_b):
    n_lat = x.shape[1]
    ROWS = n_lat // GRID_W
    rows = jnp.repeat(jnp.arange(ROWS, dtype=jnp.int32), GRID_W)
    cols = jnp.tile(jnp.arange(GRID_W, dtype=jnp.int32), ROWS)
    xl, xc = x, ctx
    for l in range(DEPTH):
        xl, xc = hybrid_layer(
            xl, xc, c, c_ctx, rows, cols, w_ada[l], b_ada[l], w_in[l], a_norm_g[l], a_norm_b[l],
            a_ws[l], a_bs[l], q_norm_g[l], k_norm_g[l], conv_w[l], conv_b[l], lru_wr[l], lru_br[l],
            lru_wi[l], lru_bi[l], lru_lam[l], w_o[l], ln_g[l], ln_b[l], with_ctx_out=(l < DEPTH - 1))
    return xl
```

```cpp
#include <hip/hip_runtime.h>
#include <hip/hip_bf16.h>
#include <cstdio>
#include <cstdint>
#include <cmath>

constexpr int DMODEL = 1024, NBATCH = 16, SEQ = 2048, CTXL = 256, DEPTH = 4;
constexpr int NLAT = NBATCH * SEQ, NCTXR = NBATCH * CTXL, MROWS = NLAT + NCTXR;
constexpr int DIN = 2560;
constexpr int ZP = 3072;
constexpr int C_MA = 0, C_Q = 256, C_HF = 768, C_HB = 1024, C_VA = 1280, C_GA = 1536, C_K = 1792, C_V = 1920, C_GB = 2048, C_RX = 2560, C_RG = 2816;
constexpr int K2 = 1280;
constexpr float ALPHA = 1.681792830507429f;
constexpr float QSCALE = 0.125f * 1.4426950408889634f;

namespace pg8 {
#define PG8_LAS __attribute__((address_space(3)))
typedef unsigned short bf16_t;
typedef short bf16x8 __attribute__((ext_vector_type(8)));
typedef float f32x4 __attribute__((ext_vector_type(4)));
typedef unsigned u32x4 __attribute__((ext_vector_type(4)));
constexpr int BM = 256, BK = 64, HALF = 128, HTB = HALF * BK * 2, STAGE_BYTES = 8 * HTB, NXCD = 8, WGM = 8;

__host__ __device__ __forceinline__ int lds_byte(int r, int c) { const int st = (r >> 4) * 2 + (c >> 5), rr = r & 15, cc = c & 31, ob = rr * 64 + cc * 2; return st * 1024 + (ob ^ (((ob >> 9) & 1) << 5)); }
__host__ __device__ __forceinline__ void stage_rc(int b, int& R, int& C) { const int st = b / 1024, sb = b % 1024, swz = sb ^ (((sb >> 9) & 1) << 5); R = (st >> 1) * 16 + swz / 64; C = (st & 1) * 32 + (swz % 64) / 2; }
__host__ __device__ __forceinline__ int perm32(int rho) { const int n = rho >> 4, i = rho & 15; return 8 * (i >> 2) + 4 * n + (i & 3); }

struct Unit { int pm, pn; };
struct Gemm { const bf16_t* A; const bf16_t* Bt; int M, N, K, lda; };

struct StaticOrder {
    int nM, nN, nwg, G, c;
    __host__ __device__ void init(int M, int N, int G_, int c_) { nM = M / BM; nN = N / BM; nwg = nM * nN; G = G_; c = c_; }
    __host__ __device__ bool next(int i, Unit& u) const {
        const long L = (long)i * G + c; if (L >= nwg) return false;
        int wgid = (int)L; { const int q = nwg / NXCD, r = nwg % NXCD, xcd = wgid % NXCD, off = wgid / NXCD; wgid = (xcd < r ? xcd * (q + 1) : r * (q + 1) + (xcd - r) * q) + off; }
        const int nig = WGM * nN, gid = wgid / nig, fm = gid * WGM, gsz = (nM - fm) < WGM ? (nM - fm) : WGM;
        u.pm = fm + ((wgid % nig) % gsz); u.pn = (wgid % nig) / gsz; return true;
    }
    __device__ __forceinline__ void a_ready(const Unit&) const {}
    __device__ __forceinline__ void done(const Unit&) const {}
};

__device__ __forceinline__ unsigned cvt_pk_bf16(float lo, float hi) { unsigned r; asm volatile("v_cvt_pk_bf16_f32 %0, %1, %2" : "=v"(r) : "v"(lo), "v"(hi)); return r; }
__device__ __forceinline__ float fast_gelu(float x) {
    const float u = 0.7978845608028654f * (x + 0.044715f * x * x * x);
    return x * __builtin_amdgcn_rcpf(1.f + __builtin_amdgcn_exp2f(-2.8853900817779268f * u));
}
__device__ __forceinline__ float fast_silu(float x) { return x * __builtin_amdgcn_rcpf(1.f + __builtin_amdgcn_exp2f(-1.4426950408889634f * x)); }

struct Epi1 {
    static constexpr bool PERM = true, AFTER_DRAIN = false;
    bf16_t* Z; const float* qg; const float* kg; const float* rope;
    __device__ __forceinline__ void operator()(const f32x4 (&acc)[2][2][4][2], const Unit& u, int wr, int wc, int fr, int fq) const {
        asm volatile("" : "+v"(fr), "+v"(fq));
        const int pn = u.pn; const int row0 = u.pm * BM + wr * 64 + fr;
        const bool qk = (pn == 3) || (pn == 4) || (pn == 5 && wc < 2);
        if (qk) {
            const float* g = (pn == 5) ? kg : qg; const float sc = (pn == 5) ? 1.f : QSCALE;
            const int dst = (pn == 5) ? (C_K + wc * 64) : (C_Q + (wc + 4 * (pn - 3)) * 64);
            f32x4 gw[2][2];
#pragma unroll
            for (int bj = 0; bj < 2; ++bj)
#pragma unroll
                for (int n = 0; n < 2; ++n) gw[bj][n] = *(const f32x4*)(g + 32 * bj + 16 * n + 4 * fq) * sc;
            const bool lat = u.pm < 128;
#pragma unroll
            for (int ai = 0; ai < 2; ++ai)
#pragma unroll
                for (int m = 0; m < 4; ++m) {
                    const int r = row0 + ai * HALF + m * 16;
                    float ss = 0.f;
#pragma unroll
                    for (int bj = 0; bj < 2; ++bj)
#pragma unroll
                        for (int n = 0; n < 2; ++n) { const f32x4 x = acc[ai][bj][m][n]; ss += (x[0] * x[0] + x[1] * x[1]) + (x[2] * x[2] + x[3] * x[3]); }
                    ss += __shfl_xor(ss, 16); ss += __shfl_xor(ss, 32);
                    const float rms = __builtin_amdgcn_rsqf(ss * (1.f / 64.f) + 1e-6f);
                    const int t = r & 2047;
                    bf16_t* zr = Z + (size_t)r * ZP + dst + 8 * fq;
#pragma unroll
                    for (int bj = 0; bj < 2; ++bj) {
                        const f32x4 x1 = acc[ai][bj][m][0] * rms * gw[bj][0], x2 = acc[ai][bj][m][1] * rms * gw[bj][1];
                        f32x4 o1 = x1, o2 = x2;
                        if (lat) { const int pos = bj ? (t & 63) : (t >> 6);
                            const f32x4 cs = *(const f32x4*)(rope + pos * 16 + 4 * fq), sn = *(const f32x4*)(rope + 1024 + pos * 16 + 4 * fq);
                            o1 = x1 * cs - x2 * sn; o2 = x1 * sn + x2 * cs; }
                        u32x4 w; w.x = cvt_pk_bf16(o1[0], o1[1]); w.y = cvt_pk_bf16(o1[2], o1[3]); w.z = cvt_pk_bf16(o2[0], o2[1]); w.w = cvt_pk_bf16(o2[2], o2[3]);
                        *(u32x4*)(zr + 32 * bj) = w;
                    }
                    asm volatile("" ::: "memory");
                }
        } else {
            int zb = 0, act = 0, bstep = HALF;
            if (pn == 0) { zb = C_MA; act = 1; } else if (pn == 1) { zb = C_VA; act = 1; } else if (pn == 2) { zb = C_GA; act = 2; }
            else if (pn == 5) { zb = C_V + (wc - 2) * 64 - wc * 32; act = 0; bstep = 32; }
            else if (pn == 6) { zb = C_GB; act = 2; } else if (pn == 7) { zb = C_GB + 256; act = 2; } else if (pn == 8) { zb = C_RX; act = 0; } else { zb = C_RG; act = 2; }
            const int col0 = zb + wc * 32 + 8 * fq;
#pragma unroll
            for (int ai = 0; ai < 2; ++ai)
#pragma unroll
                for (int m = 0; m < 4; ++m) {
                    bf16_t* zr = Z + (size_t)(row0 + ai * HALF + m * 16) * ZP + col0;
#pragma unroll
                    for (int bj = 0; bj < 2; ++bj) {
                        f32x4 v0 = acc[ai][bj][m][0], v1 = acc[ai][bj][m][1];
                        if (act == 1) {
#pragma unroll
                            for (int e = 0; e < 4; ++e) { v0[e] = fast_gelu(v0[e]); v1[e] = fast_gelu(v1[e]); }
                        } else if (act == 2) {
#pragma unroll
                            for (int e = 0; e < 4; ++e) { v0[e] = fast_silu(v0[e]); v1[e] = fast_silu(v1[e]); }
                        }
                        u32x4 w; w.x = cvt_pk_bf16(v0[0], v0[1]); w.y = cvt_pk_bf16(v0[2], v0[3]); w.z = cvt_pk_bf16(v1[0], v1[1]); w.w = cvt_pk_bf16(v1[2], v1[3]);
                        *(u32x4*)(zr + bj * bstep) = w;
                    }
                }
        }
    }
};
struct Epi2 {
    static constexpr bool PERM = false, AFTER_DRAIN = false;
    const float* xin; const float* ctxin; float* XT; const float* mods_l; int layer0;
    __device__ __forceinline__ void operator()(const f32x4 (&acc)[2][2][4][2], const Unit& u, int wr, int wc, int fr, int fq) const {
        asm volatile("" : "+v"(fr), "+v"(fq));
        const int row0 = u.pm * BM + wr * 64 + fr, col0 = u.pn * BM + wc * 32 + 4 * fq;
        const int mrow = u.pm < 128 ? (u.pm >> 3) : 16;
        const float* gp = mods_l + mrow * 3072 + 2048 + col0;
        f32x4 gv[2][2];
#pragma unroll
        for (int bj = 0; bj < 2; ++bj)
#pragma unroll
            for (int n = 0; n < 2; ++n) gv[bj][n] = *(const f32x4*)(gp + bj * HALF + n * 16);
#pragma unroll
        for (int ai = 0; ai < 2; ++ai)
#pragma unroll
            for (int m = 0; m < 4; ++m) {
                const int r = row0 + ai * HALF + m * 16;
                const float* src = layer0 ? (r < NLAT ? xin + (size_t)r * DMODEL : ctxin + (size_t)(r - NLAT) * DMODEL) : XT + (size_t)r * DMODEL;
                float* dstp = XT + (size_t)r * DMODEL + col0; src += col0;
#pragma unroll
                for (int bj = 0; bj < 2; ++bj)
#pragma unroll
                    for (int n = 0; n < 2; ++n) { const f32x4 x = *(const f32x4*)(src + bj * HALF + n * 16); *(f32x4*)(dstp + bj * HALF + n * 16) = x * ALPHA + gv[bj][n] * acc[ai][bj][m][n]; }
                if (m & 1) asm volatile("" ::: "memory");
            }
    }
};
template <class Epi, class Sched, bool ALIGN_EPI = false, bool SP2 = false>
__device__ __forceinline__ void gemm_phase(PG8_LAS unsigned char* lds, const Gemm g, const Sched& S, const Epi& E) {
    int tid_ = threadIdx.x; asm volatile("" : "+v"(tid_));
    const int tid = tid_, wid = __builtin_amdgcn_readfirstlane(tid >> 6), lane = tid & 63, wr = wid >> 2, wc = wid & 3, fr = lane & 15, fq = lane >> 4;
    const int K = g.K, nt = K / BK;
    unsigned voffA[2], voffB[2];
#pragma unroll
    for (int i = 0; i < 2; ++i) { int R, C; stage_rc(tid * 16 + i * 8192, R, C); const int Rb = Epi::PERM ? ((R & ~31) + perm32(R & 31)) : R;
        voffA[i] = (unsigned)(R * g.lda + C) * 2u; voffB[i] = (unsigned)(Rb * K + C) * 2u; }
    const size_t kstep = (size_t)(BK * 2);
    const size_t hstepA = (size_t)HALF * g.lda * 2, hstepB = (size_t)HALF * K * 2;
    const size_t tstepA = 2 * hstepA, tstepB = 2 * hstepB;
    const unsigned ldsw = (unsigned)wid * 1024u;
    const int aoff = lds_byte(wr * 64 + fr, fq * 8), boff = lds_byte(wc * 32 + fr, fq * 8);
#define PG8_SA(b, h) (((b) * 2 + (h)) * HTB)
#define PG8_SB(b, h) ((4 + (b) * 2 + (h)) * HTB)
#define PG8_STAGE(bufoff, gbase, voff) do { _Pragma("unroll") for (int _i = 0; _i < 2; ++_i) \
        __builtin_amdgcn_global_load_lds((const unsigned*)((const char*)(gbase) + (voff)[_i]), (PG8_LAS unsigned*)(lds + (bufoff) + ldsw + _i * 8192), 16, 0, 0); } while (0)
#define PG8_LDA(dst, b, h) do { _Pragma("unroll") for (int m = 0; m < 4; ++m) _Pragma("unroll") for (int k = 0; k < 2; ++k) dst[m][k] = *(const PG8_LAS bf16x8*)(lds + PG8_SA(b, h) + aoff + m * 2048 + k * 1024); } while (0)
#define PG8_LDB(dst, b, h) do { _Pragma("unroll") for (int n = 0; n < 2; ++n) _Pragma("unroll") for (int k = 0; k < 2; ++k) dst[n][k] = *(const PG8_LAS bf16x8*)(lds + PG8_SB(b, h) + boff + n * 2048 + k * 1024); } while (0)
#define PG8_MMA(ai, bj, At, Bt) do { __builtin_amdgcn_s_setprio(1); _Pragma("unroll") for (int m = 0; m < 4; ++m) _Pragma("unroll") for (int n = 0; n < 2; ++n) _Pragma("unroll") for (int k = 0; k < 2; ++k) \
        acc[ai][bj][m][n] = __builtin_amdgcn_mfma_f32_16x16x32_bf16(Bt[n][k], At[m][k], acc[ai][bj][m][n], 0, 0, 0); __builtin_amdgcn_s_setprio(0); } while (0)
#define PG8_WAIT_V(n) asm volatile("s_waitcnt vmcnt(" #n ")" ::: "memory")
#define PG8_WAIT_L(n) asm volatile("s_waitcnt lgkmcnt(" #n ")" ::: "memory")
#define PG8_BAR __builtin_amdgcn_s_barrier()
#define PG8_SCHED __builtin_amdgcn_sched_barrier(0)
    Unit cur, nxt; int ui = 0;
    if (!S.next(0, cur)) return;
    f32x4 acc[2][2][4][2];
#pragma unroll
    for (int a = 0; a < 2; ++a)
#pragma unroll
        for (int b = 0; b < 2; ++b)
#pragma unroll
            for (int m = 0; m < 4; ++m)
#pragma unroll
                for (int n = 0; n < 2; ++n) acc[a][b][m][n] = (f32x4){0.f, 0.f, 0.f, 0.f};
    bf16x8 At[4][2], B0[2][2], B1[2][2];
    const char* cA = (const char*)g.A + (size_t)cur.pm * tstepA; const char* cB = (const char*)g.Bt + (size_t)cur.pn * tstepB;
    S.a_ready(cur);
    if constexpr (SP2) {
        PG8_STAGE(PG8_SB(0, 0), cB, voffB); PG8_STAGE(PG8_SB(0, 1), cB + hstepB, voffB); PG8_STAGE(PG8_SA(0, 0), cA, voffA); PG8_STAGE(PG8_SA(0, 1), cA + hstepA, voffA);
        if (wr == 1) PG8_BAR;
        PG8_WAIT_V(2); PG8_BAR;
        PG8_STAGE(PG8_SB(1, 0), cB + kstep, voffB); PG8_STAGE(PG8_SA(1, 0), cA + kstep, voffA); PG8_STAGE(PG8_SB(1, 1), cB + hstepB + kstep, voffB);
        PG8_WAIT_V(6); PG8_BAR;
    } else {
        PG8_STAGE(PG8_SB(0, 0), cB, voffB); PG8_STAGE(PG8_SA(0, 0), cA, voffA); PG8_STAGE(PG8_SB(0, 1), cB + hstepB, voffB); PG8_STAGE(PG8_SA(0, 1), cA + hstepA, voffA);
        if (wr == 1) PG8_BAR;
        PG8_WAIT_V(4); PG8_BAR;
        PG8_STAGE(PG8_SB(1, 0), cB + kstep, voffB); PG8_STAGE(PG8_SA(1, 0), cA + kstep, voffA); PG8_STAGE(PG8_SB(1, 1), cB + hstepB + kstep, voffB);
        PG8_WAIT_V(6); PG8_BAR;
    }
    for (;;) {
        const bool has_next = S.next(ui + 1, nxt);
        const char* nA = has_next ? (const char*)g.A + (size_t)nxt.pm * tstepA : cA; const char* nB = has_next ? (const char*)g.Bt + (size_t)nxt.pn * tstepB : cB;
        for (int t = 0; t < nt; t += 2) {
            const bool last = (t == nt - 2);
            const char* a1 = cA + (size_t)(t + 1) * kstep;
            const char* a2 = last ? nA : cA + (size_t)(t + 2) * kstep; const char* b2 = last ? nB : cB + (size_t)(t + 2) * kstep;
            const char* a3 = a2 + kstep; const char* b3 = b2 + kstep;
            if (last && has_next) S.a_ready(nxt);
            if constexpr (SP2) {
            PG8_LDB(B0, 0, 0); PG8_LDB(B1, 0, 1); PG8_SCHED; PG8_LDA(At, 0, 0); PG8_STAGE(PG8_SA(1, 1), a1 + hstepA, voffA);
            PG8_WAIT_V(8); PG8_WAIT_L(0); PG8_BAR; PG8_MMA(0, 0, At, B0); PG8_MMA(0, 1, At, B1); PG8_BAR; PG8_SCHED;
            PG8_LDA(At, 0, 1); PG8_STAGE(PG8_SB(0, 0), b2, voffB); PG8_STAGE(PG8_SB(0, 1), b2 + hstepB, voffB); PG8_STAGE(PG8_SA(0, 0), a2, voffA);
            PG8_WAIT_V(8); PG8_WAIT_L(0); PG8_BAR; PG8_MMA(1, 0, At, B0); PG8_MMA(1, 1, At, B1); PG8_BAR; PG8_SCHED;
            PG8_LDB(B0, 1, 0); PG8_LDB(B1, 1, 1); PG8_SCHED; PG8_LDA(At, 1, 0); PG8_STAGE(PG8_SA(0, 1), a2 + hstepA, voffA);
            PG8_WAIT_V(8); PG8_WAIT_L(0); PG8_BAR; PG8_MMA(0, 0, At, B0); PG8_MMA(0, 1, At, B1); PG8_BAR; PG8_SCHED;
            PG8_LDA(At, 1, 1); PG8_STAGE(PG8_SB(1, 0), b3, voffB); PG8_STAGE(PG8_SB(1, 1), b3 + hstepB, voffB); PG8_STAGE(PG8_SA(1, 0), a3, voffA);
            PG8_WAIT_V(8); PG8_WAIT_L(0); PG8_BAR; PG8_MMA(1, 0, At, B0); PG8_MMA(1, 1, At, B1); PG8_BAR; PG8_SCHED;
            } else {
            PG8_LDB(B0, 0, 0); PG8_SCHED; PG8_LDA(At, 0, 0); PG8_STAGE(PG8_SA(1, 1), a1 + hstepA, voffA);
            PG8_WAIT_L(8); PG8_BAR; PG8_WAIT_L(0); PG8_MMA(0, 0, At, B0); PG8_BAR; PG8_SCHED;
            PG8_LDB(B1, 0, 1); PG8_STAGE(PG8_SB(0, 0), b2, voffB);
            PG8_BAR; PG8_WAIT_L(0); PG8_MMA(0, 1, At, B1); PG8_BAR;
            PG8_LDA(At, 0, 1); PG8_STAGE(PG8_SA(0, 0), a2, voffA);
            PG8_BAR; PG8_WAIT_L(0); PG8_MMA(1, 0, At, B0); PG8_BAR; PG8_SCHED;
            PG8_STAGE(PG8_SB(0, 1), b2 + hstepB, voffB);
            PG8_WAIT_V(6); PG8_BAR; PG8_MMA(1, 1, At, B1); PG8_BAR;
            PG8_LDB(B0, 1, 0); PG8_SCHED; PG8_LDA(At, 1, 0); PG8_STAGE(PG8_SA(0, 1), a2 + hstepA, voffA);
            PG8_WAIT_L(8); PG8_BAR; PG8_WAIT_L(0); PG8_MMA(0, 0, At, B0); PG8_BAR; PG8_SCHED;
            PG8_LDB(B1, 1, 1); PG8_STAGE(PG8_SB(1, 0), b3, voffB);
            PG8_BAR; PG8_WAIT_L(0); PG8_MMA(0, 1, At, B1); PG8_BAR;
            PG8_LDA(At, 1, 1); PG8_STAGE(PG8_SA(1, 0), a3, voffA);
            PG8_BAR; PG8_WAIT_L(0); PG8_MMA(1, 0, At, B0); PG8_BAR; PG8_SCHED;
            PG8_STAGE(PG8_SB(1, 1), b3 + hstepB, voffB);
            PG8_WAIT_V(6); PG8_BAR; PG8_MMA(1, 1, At, B1); PG8_BAR;
            }
        }
        if constexpr (ALIGN_EPI) { if (wr == 0) PG8_BAR; }
        if constexpr (!Epi::AFTER_DRAIN) { E(acc, cur, wr, wc, fr, fq); S.done(cur); }
        if (!has_next) break;
#pragma unroll
        for (int a = 0; a < 2; ++a)
#pragma unroll
            for (int b = 0; b < 2; ++b)
#pragma unroll
                for (int m = 0; m < 4; ++m)
#pragma unroll
                    for (int n = 0; n < 2; ++n) acc[a][b][m][n] = (f32x4){0.f, 0.f, 0.f, 0.f};
        cur = nxt; cA = nA; cB = nB; ++ui;
        if constexpr (ALIGN_EPI) { if (wr == 1) PG8_BAR; }
    }
    PG8_WAIT_V(0);
    if constexpr (!ALIGN_EPI) { if (wr == 0) PG8_BAR; }
    PG8_BAR;
    if constexpr (Epi::AFTER_DRAIN) { E.fused(acc, cur, wr, wc, fr, fq, lds, wid, lane); S.done(cur); }
#undef PG8_SA
#undef PG8_SB
#undef PG8_STAGE
#undef PG8_LDA
#undef PG8_LDB
#undef PG8_MMA
#undef PG8_WAIT_V
#undef PG8_WAIT_L
#undef PG8_BAR
#undef PG8_SCHED
}
}
namespace attn_body {
using bf16=__hip_bfloat16;
using bf16x8=__attribute__((ext_vector_type(8)))short;
using s16x4=__attribute__((ext_vector_type(4)))short;
using f32x16=__attribute__((ext_vector_type(16)))float;
using u32x4=__attribute__((ext_vector_type(4)))unsigned;
constexpr int D=64,DM=ZP;
constexpr int NW=8,QBLK=32,QB=QBLK*NW,KVBLK=64;
constexpr int ATTN_PITCH=DM, ATTN_UNIT_ROWS=QB;
__device__ __forceinline__ int crow(int r,int hi){return (r&3)+8*(r>>2)+4*hi;}
#define SBAR() __builtin_amdgcn_sched_barrier(0)
__device__ __forceinline__ void cmask(f32x16&p0,f32x16&p1,int jb,int qrel,int hi){
  const float NEG=-INFINITY; int kb=64*jb+4*hi;
  #pragma unroll
  for(int r=0;r<16;++r){int kv=kb+(r&3)+8*(r>>2); if(kv>qrel)p0[r]=NEG; if(kv+32>qrel)p1[r]=NEG;}
}

constexpr int NSLOT=3, SLOTB=8192;
constexpr int LDS_K=0, LDS_V=NSLOT*SLOTB, LDS_WS=2*NSLOT*SLOTB, LDS_OST=LDS_WS+NW*64*4, LDS_BYTES=LDS_OST+NW*4096;
constexpr float C2=0.125f*1.4426950408889634f;
__device__ __forceinline__ void glds16(const void*gsrc,unsigned lds_dst){unsigned keep;
  asm volatile("s_mov_b32 %0, m0\n\ts_mov_b32 m0, %2\n\ts_nop 0\n\tglobal_load_lds_dwordx4 %1, off\n\ts_mov_b32 m0, %0":"=&s"(keep):"v"(gsrc),"s"(lds_dst):"memory");}
__device__ __forceinline__ float max3f(float a,float b,float c){float r;asm("v_max3_f32 %0, %1, %2, %3":"=v"(r):"v"(a),"v"(b),"v"(c));return r;}
__device__ __forceinline__ float max2f(float a,float b){float r;asm("v_max_f32_e32 %0, %1, %2":"=v"(r):"v"(a),"v"(b));return r;}
__device__ __forceinline__ float fadd_s(float a,float b){float r;asm("v_add_f32_e32 %0, %1, %2":"=v"(r):"v"(a),"v"(b));return r;}
__device__ __forceinline__ float fsub_s(float a,float b){float r;asm("v_sub_f32_e32 %0, %1, %2":"=v"(r):"v"(a),"v"(b));return r;}
typedef float f32x2_t __attribute__((ext_vector_type(2))); typedef __bf16 bf16x2_t __attribute__((ext_vector_type(2)));
__device__ __forceinline__ unsigned cvtpk_s(float lo,float hi){f32x2_t v={lo,hi};bf16x2_t b=__builtin_convertvector(v,bf16x2_t);return __builtin_bit_cast(unsigned,b);}
#define WAIT_BAR(N) asm volatile("s_waitcnt vmcnt(" #N ") lgkmcnt(0)\n\ts_barrier":::"memory")

__device__ __forceinline__ void qkt(f32x16&p0,f32x16&p1,const char*Kslot,const bf16x8*qr,const f32x16&negm,int r32,int hi){
  const char*kb=Kslot+hi*1024+r32*16;
  #pragma unroll
  for(int d0=0;d0<4;++d0){
    const bf16x8 b0=*reinterpret_cast<const bf16x8*>(kb+d0*2048);
    const bf16x8 b1=*reinterpret_cast<const bf16x8*>(kb+d0*2048+512);
    if(d0==0){p0=__builtin_amdgcn_mfma_f32_32x32x16_bf16(b0,qr[0],negm,0,0,0);p1=__builtin_amdgcn_mfma_f32_32x32x16_bf16(b1,qr[0],negm,0,0,0);}
    else{p0=__builtin_amdgcn_mfma_f32_32x32x16_bf16(b0,qr[d0],p0,0,0,0);p1=__builtin_amdgcn_mfma_f32_32x32x16_bf16(b1,qr[d0],p1,0,0,0);}}
}
typedef __attribute__((address_space(3))) const char* lds_cptr;
typedef short v4i16_t __attribute__((ext_vector_type(4)));
__device__ __forceinline__ void kload8(bf16x8*kf,lds_cptr kp){
  kf[0]=*(const __attribute__((address_space(3))) bf16x8*)(kp);      kf[1]=*(const __attribute__((address_space(3))) bf16x8*)(kp+512);
  kf[2]=*(const __attribute__((address_space(3))) bf16x8*)(kp+2048); kf[3]=*(const __attribute__((address_space(3))) bf16x8*)(kp+2560);
  kf[4]=*(const __attribute__((address_space(3))) bf16x8*)(kp+4096); kf[5]=*(const __attribute__((address_space(3))) bf16x8*)(kp+4608);
  kf[6]=*(const __attribute__((address_space(3))) bf16x8*)(kp+6144); kf[7]=*(const __attribute__((address_space(3))) bf16x8*)(kp+6656);
}
__device__ __forceinline__ void kload2(bf16x8*kf,lds_cptr kp,int j){ kf[2*j]=*(const __attribute__((address_space(3))) bf16x8*)(kp+j*2048); kf[2*j+1]=*(const __attribute__((address_space(3))) bf16x8*)(kp+j*2048+512); }
__device__ __forceinline__ s16x4 vtr(lds_cptr p){ return __builtin_bit_cast(s16x4,__builtin_amdgcn_ds_read_tr16_b64_v4i16((__attribute__((address_space(3))) v4i16_t*)p)); }
__device__ __forceinline__ float rowmax(const f32x16&p0,const f32x16&p1){
  float a=max3f(p0[0],p0[1],p1[0]),b=max3f(p0[2],p0[3],p1[1]);a=max3f(a,p1[2],p1[3]);
  #pragma unroll
  for(int r=4;r<16;r+=4){a=max3f(a,p0[r],p0[r+1]);b=max3f(b,p0[r+2],p0[r+3]);a=max3f(a,p1[r],p1[r+1]);b=max3f(b,p1[r+2],p1[r+3]);}
  const float m=max2f(a,b);
  auto rr=__builtin_amdgcn_permlane32_swap(__float_as_uint(m),__float_as_uint(m),false,false);
  return max2f(__uint_as_float(rr[0]),__uint_as_float(rr[1]));
}
__device__ __forceinline__ void pv(f32x16*o,int vb,bf16x8 pa0,bf16x8 pa1,bf16x8 pa2,bf16x8 pa3){
  #pragma unroll
  for(int d0=0;d0<2;++d0){s16x4 lo[4],hi[4];
    #pragma unroll
    for(int ks=0;ks<4;++ks){
      asm volatile("ds_read_b64_tr_b16 %0,%1 offset:%c2":"=&v"(lo[ks]):"v"(vb),"i"(d0*4096+ks*1024):"memory");
      asm volatile("ds_read_b64_tr_b16 %0,%1 offset:%c2":"=&v"(hi[ks]):"v"(vb),"i"(d0*4096+ks*1024+512):"memory");}
    asm volatile("s_waitcnt lgkmcnt(0)":::"memory");SBAR();
    #define PK(k) (bf16x8){lo[k][0],lo[k][1],lo[k][2],lo[k][3],hi[k][0],hi[k][1],hi[k][2],hi[k][3]}
    o[d0]=__builtin_amdgcn_mfma_f32_32x32x16_bf16(pa0,PK(0),o[d0],0,0,0);
    o[d0]=__builtin_amdgcn_mfma_f32_32x32x16_bf16(pa1,PK(1),o[d0],0,0,0);
    o[d0]=__builtin_amdgcn_mfma_f32_32x32x16_bf16(pa2,PK(2),o[d0],0,0,0);
    o[d0]=__builtin_amdgcn_mfma_f32_32x32x16_bf16(pa3,PK(3),o[d0],0,0,0);
    #undef PK
  }
}

#ifndef ATTN_STORE16
#define ATTN_STORE16(p,v) (*(u32x4*)(p)=(v))
#endif
template<int THRL> __device__ __forceinline__ void attn_unit(const bf16*Qu,const bf16*K0,const bf16*K1,int nt0,int NT,char*shm){
  int tid_=threadIdx.x; asm volatile("":"+v"(tid_));
  const int tid=tid_,lane=tid&63,r32=lane&31,hi=lane>>5; const int wid=__builtin_amdgcn_readfirstlane(tid>>6);
  const bf16*Qw=Qu+(long)(wid*QBLK)*DM;
  const unsigned lds0=(unsigned)(uintptr_t)shm;
  float*wsf=(float*)(shm+LDS_WS)+wid*64;
  const bf16*ksrc0=K0+(long)lane*DM+wid*8,*ksrc1=K1+(long)lane*DM+wid*8;
  const long voff_=(long)(16*(wid&3)+(lane>>2))*DM+(wid>>2)*32+(lane&3)*8+(C_V-C_K); const bf16*vsrc0=K0+voff_,*vsrc1=K1+voff_;
  const unsigned kdst=lds0+LDS_K+wid*1024, vdst=lds0+LDS_V+wid*1024;
  #define DMA_K(t,slot) glds16(((t)<nt0?ksrc0+(long)(t)*KVBLK*DM:ksrc1+(long)((t)-nt0)*KVBLK*DM),(unsigned)__builtin_amdgcn_readfirstlane(kdst+(slot)))
  #define DMA_V(t,slot) glds16(((t)<nt0?vsrc0+(long)(t)*KVBLK*DM:vsrc1+(long)((t)-nt0)*KVBLK*DM),(unsigned)__builtin_amdgcn_readfirstlane(vdst+(slot)))
  const int vb0=(int)(lds0+LDS_V)+((lane>>4)&1)*32+(lane&3)*8+(4*hi+((lane&15)>>2))*64;
  const char*Kbase=shm+LDS_K; bf16x8 kf[8];
  const lds_cptr shm3=(lds_cptr)shm; const lds_cptr kp0=shm3+LDS_K+hi*1024+r32*16; const lds_cptr vp0=shm3+LDS_V+((lane>>4)&1)*32+(lane&3)*8+(4*hi+((lane&15)>>2))*64;
  DMA_K(0,0);DMA_V(0,0);DMA_K(1,SLOTB);
  bf16x8 qr[4];
  #pragma unroll
  for(int d0=0;d0<4;++d0)qr[d0]=*reinterpret_cast<const bf16x8*>(&Qw[(long)r32*DM+d0*16+hi*8]);
  float mhat=0.f,l_reg=0.f;f32x16 o[2];o[0]=f32x16{};o[1]=f32x16{};f32x16 negm=f32x16{};asm volatile("":"+v"(negm));
  #define CMASK(P0,P1,t) do{}while(0)
  bool resc=false;
  #define START(P0,P1) do{ const float rm=rowmax(P0,P1); resc=false; \
    { const float dl=rm; mhat=fadd_s(mhat,dl); \
      _Pragma("unroll") for(int r=0;r<16;++r){P0[r]=fsub_s(P0[r],dl);P1[r]=fsub_s(P1[r],dl);} \
      _Pragma("unroll") for(int r=0;r<16;++r)negm[r]=-mhat; asm volatile("":"+v"(negm)); } \
    _Pragma("unroll") for(int r=0;r<16;++r)P0[r]=__builtin_amdgcn_exp2f(P0[r]); }while(0)
  #define RESC() do{ if(resc){ asm volatile("s_waitcnt lgkmcnt(0)":::"memory"); \
      _Pragma("unroll") for(int d_=0;d_<2;++d_) _Pragma("unroll") for(int r=0;r<16;++r)o[d_][r]*=wsf[crow(r,hi)]; } }while(0)
  f32x16 pA0,pA1,pB0,pB1;
  int sl_prev=0,sl_cur=0,sl_next=SLOTB;
  #define ROT() do{sl_prev=sl_cur;sl_cur=sl_next;sl_next=(sl_next==(NSLOT-1)*SLOTB)?0:sl_next+SLOTB;}while(0)
  DMA_K(2,2*SLOTB);
  WAIT_BAR(3);
  qkt(pA0,pA1,Kbase,qr,negm,r32,hi);asm volatile("s_nop 15\n\ts_nop 7":"+v"(pA0),"+v"(pA1));CMASK(pA0,pA1,0);
  START(pA0,pA1);
  _Pragma("unroll") for(int r=0;r<16;++r)pA1[r]=__builtin_amdgcn_exp2f(pA1[r]);
  WAIT_BAR(0);
  DMA_K(3,0);DMA_V(1,SLOTB);
  ROT();
  kload8(kf,kp0+sl_cur);
  WAIT_BAR(2);
  s16x4 vlo[8],vhi[8]; u32x4 pw0,pw1,pw2,pw3;
  #define PKW(P,B) cvtpk_s(P[B],P[B+1])
  #define PAF(k) __builtin_bit_cast(bf16x8,pw##k)
  #define VFR(i) (bf16x8){vlo[i][0],vlo[i][1],vlo[i][2],vlo[i][3],vhi[i][0],vhi[i][1],vhi[i][2],vhi[i][3]}
  #define PIN(x) asm volatile("":"+v"(x))
  #define MX3(a,b,c) __builtin_fmaxf(__builtin_fmaxf((a),(b)),(c))
  #define GAPA(MF,A0,A1,A2,A3,W0,W1,PW) do{ MF; sacc+=A0; sacc+=A1; sacc+=A2; sacc+=A3; PIN(sacc); W0; W1; PIN(PW); SBAR(); }while(0)
  #define EX(v) __builtin_amdgcn_exp2f(v)
  #define GAPB(MF,X,B) do{ MF; X[B]=EX(X[B]); X[B+1]=EX(X[B+1]); X[B+2]=EX(X[B+2]); X[B+3]=EX(X[B+3]); PIN(X); SBAR(); }while(0)
  #define VRD(i) do{ vlo[i]=vtr(vp_+(((i)>>2)*4096+((i)&3)*1024)); vhi[i]=vtr(vp_+(((i)>>2)*4096+((i)&3)*1024+512)); }while(0)
  #define KRD(G,j) do{ if(G){ kload2(kf,kp0+sl_next,j); SBAR(); } }while(0)
  #define STEP(C0,C1,P0,P1,t,GK,GV,GL) do{ SBAR(); \
    const lds_cptr vp_=vp0+sl_prev; \
    VRD(0); SBAR(); float sacc=(P0[0]+P0[1]); \
    GAPA(C0=__builtin_amdgcn_mfma_f32_32x32x16_bf16(kf[0],qr[0],negm,0,0,0), P0[2],P0[3],P0[4],P0[5],     pw0[0]=PKW(P0,0), pw0[1]=PKW(P0,2), pw0); \
    VRD(4); SBAR(); GAPA(C1=__builtin_amdgcn_mfma_f32_32x32x16_bf16(kf[1],qr[0],negm,0,0,0), P0[6],P0[7],P0[8],P0[9],     pw0[2]=PKW(P0,4), pw0[3]=PKW(P0,6), pw0); \
    VRD(1); SBAR(); GAPA(C0=__builtin_amdgcn_mfma_f32_32x32x16_bf16(kf[2],qr[1],C0,0,0,0),   P0[10],P0[11],P0[12],P0[13], pw1[0]=PKW(P0,8), pw1[1]=PKW(P0,10), pw1); \
    VRD(5); SBAR(); GAPA(C1=__builtin_amdgcn_mfma_f32_32x32x16_bf16(kf[3],qr[1],C1,0,0,0),   P0[14],P0[15],P1[0],P1[1],   pw1[2]=PKW(P0,12),pw1[3]=PKW(P0,14), pw1); \
    VRD(2); SBAR(); GAPA(C0=__builtin_amdgcn_mfma_f32_32x32x16_bf16(kf[4],qr[2],C0,0,0,0),   P1[2],P1[3],P1[4],P1[5],     pw2[0]=PKW(P1,0), pw2[1]=PKW(P1,2), pw2); \
    VRD(6); SBAR(); GAPA(C1=__builtin_amdgcn_mfma_f32_32x32x16_bf16(kf[5],qr[2],C1,0,0,0),   P1[6],P1[7],P1[8],P1[9],     pw2[2]=PKW(P1,4), pw2[3]=PKW(P1,6), pw2); \
    VRD(3); SBAR(); GAPA(C0=__builtin_amdgcn_mfma_f32_32x32x16_bf16(kf[6],qr[3],C0,0,0,0),   P1[10],P1[11],P1[12],P1[13], pw3[0]=PKW(P1,8), pw3[1]=PKW(P1,10), pw3); \
    VRD(7); SBAR(); GAPA(C1=__builtin_amdgcn_mfma_f32_32x32x16_bf16(kf[7],qr[3],C1,0,0,0),   P1[14],P1[15],0.f,0.f,       pw3[2]=PKW(P1,12),pw3[3]=PKW(P1,14), pw3); \
    l_reg+=sacc; \
    if(GK){DMA_K((t)+3,sl_cur);} if(GV){DMA_V((t)+1,sl_next);} \
    CMASK(C0,C1,t); \
    { float a=MX3(C0[0],C0[1],C1[0]),b=MX3(C0[2],C0[3],C1[1]); a=MX3(a,C1[2],C1[3]); \
      _Pragma("unroll") for(int r=4;r<16;r+=4){a=MX3(a,C0[r],C0[r+1]);b=MX3(b,C0[r+2],C0[r+3]);a=MX3(a,C1[r],C1[r+1]);b=MX3(b,C1[r+2],C1[r+3]);} \
      float rm=__builtin_fmaxf(a,b); { auto rr=__builtin_amdgcn_permlane32_swap(__float_as_uint(rm),__float_as_uint(rm),false,false); rm=__builtin_fmaxf(__uint_as_float(rr[0]),__uint_as_float(rr[1])); } \
      resc=false; \
      if(__builtin_expect(__any(rm>(float)THRL),0)){ const float dl=__builtin_fmaxf(rm,0.f); mhat+=dl; \
        _Pragma("unroll") for(int r=0;r<16;++r){C0[r]-=dl;C1[r]-=dl;} \
        _Pragma("unroll") for(int r=0;r<16;++r)negm[r]=-mhat; asm volatile("":"+v"(negm)); \
        const float f=__builtin_amdgcn_exp2f(-dl); l_reg*=f; if(hi==0)wsf[r32]=f; resc=true; } } \
    SBAR(); \
    GAPB(o[0]=__builtin_amdgcn_mfma_f32_32x32x16_bf16(PAF(0),VFR(0),o[0],0,0,0), C0,0); \
    GAPB(o[1]=__builtin_amdgcn_mfma_f32_32x32x16_bf16(PAF(0),VFR(4),o[1],0,0,0), C0,4); \
    KRD(GL,0); GAPB(o[0]=__builtin_amdgcn_mfma_f32_32x32x16_bf16(PAF(1),VFR(1),o[0],0,0,0), C0,8); \
    KRD(GL,1); GAPB(o[1]=__builtin_amdgcn_mfma_f32_32x32x16_bf16(PAF(1),VFR(5),o[1],0,0,0), C0,12); \
    KRD(GL,2); GAPB(o[0]=__builtin_amdgcn_mfma_f32_32x32x16_bf16(PAF(2),VFR(2),o[0],0,0,0), C1,0); \
    KRD(GL,3); GAPB(o[1]=__builtin_amdgcn_mfma_f32_32x32x16_bf16(PAF(2),VFR(6),o[1],0,0,0), C1,4); \
    GAPB(o[0]=__builtin_amdgcn_mfma_f32_32x32x16_bf16(PAF(3),VFR(3),o[0],0,0,0), C1,8); \
    GAPB(o[1]=__builtin_amdgcn_mfma_f32_32x32x16_bf16(PAF(3),VFR(7),o[1],0,0,0), C1,12); \
    }while(0)
  int t=1;
  #undef CMASK
  #define CMASK(P0,P1,t) do{}while(0)
  for(;t+5<NT;t+=2){
    STEP(pB0,pB1,pA0,pA1,t,true,true,true);     WAIT_BAR(2); RESC(); ROT();
    STEP(pA0,pA1,pB0,pB1,t+1,true,true,true);   WAIT_BAR(2); RESC(); ROT();
  }
  #undef CMASK
  #define CMASK(P0,P1,t) do{}while(0)
  #define ENDW(tt) do{ if((tt)+3<NT){WAIT_BAR(2);} else if((tt)+2<NT){WAIT_BAR(1);} else {WAIT_BAR(0);} }while(0)
  for(;t+1<NT;t+=2){
    STEP(pB0,pB1,pA0,pA1,t,(t+3<NT),(t+1<NT),(t+1<NT));       ENDW(t);   RESC(); ROT();
    STEP(pA0,pA1,pB0,pB1,t+1,(t+4<NT),(t+2<NT),(t+2<NT));     ENDW(t+1); RESC(); ROT();
  }
  STEP(pB0,pB1,pA0,pA1,NT-1,false,false,false); RESC();
  { float sacc=pB0[0]+pB0[1]; _Pragma("unroll") for(int r=2;r<16;++r)sacc+=pB0[r]; _Pragma("unroll") for(int r=0;r<16;++r)sacc+=pB1[r]; l_reg+=sacc;
    pw0=(u32x4){PKW(pB0,0),PKW(pB0,2),PKW(pB0,4),PKW(pB0,6)};pw1=(u32x4){PKW(pB0,8),PKW(pB0,10),PKW(pB0,12),PKW(pB0,14)};pw2=(u32x4){PKW(pB1,0),PKW(pB1,2),PKW(pB1,4),PKW(pB1,6)};pw3=(u32x4){PKW(pB1,8),PKW(pB1,10),PKW(pB1,12),PKW(pB1,14)};
    SBAR(); pv(o,vb0+sl_cur,PAF(0),PAF(1),PAF(2),PAF(3)); }
  #undef PKW
  #undef PAF
  #undef VFR
  #undef PIN
  #undef MX3
  #undef GAPA
  #undef GAPB
  #undef EX
  #undef VRD
  #undef KRD
  #undef STEP
  #undef ENDW
  {auto rr=__builtin_amdgcn_permlane32_swap(__float_as_uint(l_reg),__float_as_uint(l_reg),false,false);l_reg=__uint_as_float(rr[0])+__uint_as_float(rr[1]);}
  if(hi==0)wsf[32+r32]=l_reg;asm volatile("s_waitcnt lgkmcnt(0)":::"memory");
  float rli[16];
  #pragma unroll
  for(int r=0;r<16;++r)rli[r]=__builtin_amdgcn_rcpf(wsf[32+crow(r,hi)]);
  bf16*Ow=(bf16*)Qw; const bf16*Gw=Qw+(C_GB-C_Q);
  { bf16*stg=(bf16*)(shm+LDS_OST)+wid*2048;
    #pragma unroll
    for(int r=0;r<16;++r){const int orow=crow(r,hi);
      #pragma unroll
      for(int d0=0;d0<2;++d0)stg[orow*64+d0*32+r32]=__float2bfloat16(o[d0][r]*rli[r]);}
    asm volatile("s_waitcnt lgkmcnt(0)":::"memory");
    #pragma unroll
    for(int i=0;i<4;++i){const int row=i*8+(lane>>3),ch=lane&7; const u32x4 v=*(const u32x4*)(stg+row*64+ch*8); const u32x4 gt=*(const u32x4*)(Gw+(long)row*DM+ch*8); u32x4 w;
      #pragma unroll
      for(int q_=0;q_<4;++q_){ const float a0=__uint_as_float(v[q_]<<16)*__uint_as_float(gt[q_]<<16), a1=__uint_as_float(v[q_]&0xffff0000u)*__uint_as_float(gt[q_]&0xffff0000u); w[q_]=cvtpk_s(a0,a1); }
      ATTN_STORE16(Ow+(long)row*DM+ch*8,w);} }
  asm volatile("s_waitcnt lgkmcnt(0)\n\ts_barrier":::"memory");
  #undef DMA_K
  #undef DMA_V
  #undef CMASK
  #undef START
  #undef RESC
  #undef ROT
}
constexpr int ATTN_LDS_BYTES=LDS_BYTES;
#undef SBAR
#undef WAIT_BAR
}

constexpr int NWAVES = 8;
#ifndef MK_PER_PHASE
#define MK_PER_PHASE 0
#endif
constexpr size_t MiB = 1u << 20;
constexpr size_t WS_CTL = 0, CTL_ZERO_BYTES = 1 * MiB;
constexpr size_t WS_MODS = 1 * MiB, WS_ROPE = 2 * MiB, WS_AWS = 2 * MiB + 512 * 1024, WS_LRUW = 3 * MiB, WS_WIN = 4 * MiB, WS_WO = 24 * MiB, WS_XR = 34 * MiB,
                 WS_XM = 52 * MiB, WS_XT = 124 * MiB, WS_Z = 268 * MiB, WS_END = 484 * MiB;
static_assert(WS_WIN + (size_t)DEPTH * DIN * DMODEL * 2 <= WS_WO && WS_WO + (size_t)DEPTH * DMODEL * K2 * 2 <= WS_XR && WS_XR + (size_t)MROWS * 256 * 2 <= WS_XM &&
              WS_XM + (size_t)MROWS * DMODEL * 2 <= WS_XT && WS_XT + (size_t)MROWS * DMODEL * 4 <= WS_Z && WS_Z + (size_t)MROWS * ZP * 2 <= WS_END, "d_ws map");
constexpr int CW_BAR = 4096, CW_Q = 16384;
constexpr int RING_OFF = 0, RING_BYTES = 131072, LDSCTL_OFF = RING_BYTES, MISC_OFF = LDSCTL_OFF + 320, LDS_BYTES = 147456;
constexpr int NPHASE = 2 + 4 * DEPTH;

#define GAS __attribute__((address_space(1)))
#define LAS __attribute__((address_space(3)))
typedef unsigned short bf16;
typedef unsigned v4u __attribute__((ext_vector_type(4)));
typedef unsigned v2u __attribute__((ext_vector_type(2)));
typedef float f32x4 __attribute__((ext_vector_type(4)));
typedef float f32x16 __attribute__((ext_vector_type(16)));
typedef short bf16x8 __attribute__((ext_vector_type(8)));
typedef GAS unsigned gu32;
#define RLX_AGENT __ATOMIC_RELAXED, __HIP_MEMORY_SCOPE_AGENT
#define LDS_WAIT() asm volatile("s_waitcnt lgkmcnt(0)" ::: "memory")
#define VM_WAIT() asm volatile("s_waitcnt vmcnt(0)" ::: "memory")
__device__ __forceinline__ unsigned f2bf(float f) { unsigned u = __builtin_bit_cast(unsigned, f); return (u + 0x7fffu + ((u >> 16) & 1u)) >> 16; }
__device__ __forceinline__ unsigned pk2(float lo, float hi) { return f2bf(lo) | (f2bf(hi) << 16); }
__device__ __forceinline__ float bflo(unsigned w) { return __uint_as_float(w << 16); }
__device__ __forceinline__ float bfhi(unsigned w) { return __uint_as_float(w & 0xffff0000u); }
__device__ __forceinline__ float bf1(bf16 h) { return __uint_as_float((unsigned)h << 16); }
__device__ __forceinline__ int crow16(int r, int hi) { return (r & 3) + 8 * (r >> 2) + 4 * hi; }

#define XB_TMO      128
#define XB_XCNT(j)  (256  + 64 * (j))
#define XB_XSUB(j)  (1280 + 64 * (j))
#define XB_XGEN(j)  (2304 + 64 * (j))
#define XB_TOP      3328
#define XB_TOPGEN   3392
#define XCD_BAR_WORDS 3456
#define XB_SPIN_CAP (1u << 20)
__device__ __forceinline__ unsigned xb_ld(unsigned* p)              { return __hip_atomic_load(p, __ATOMIC_RELAXED, __HIP_MEMORY_SCOPE_AGENT); }
__device__ __forceinline__ unsigned xb_add(unsigned* p, unsigned v) { return __hip_atomic_fetch_add(p, v, __ATOMIC_RELAXED, __HIP_MEMORY_SCOPE_AGENT); }
__device__ __forceinline__ unsigned xb_xcc_id() { return (unsigned)__builtin_amdgcn_s_getreg((3 << 11) | 20) & 0xFu; }
#define XB_SPIN(cond, bar) do { unsigned _sp = 0; while (cond) { __builtin_amdgcn_s_sleep(1); \
    if ((++_sp & 255u) == 0u) { if (xb_ld(&(bar)[XB_TMO])) break; if (_sp > XB_SPIN_CAP) { atomicAdd(&(bar)[XB_TMO], 1u); break; } } } } while (0)
struct XcdBarrier { unsigned* bar; unsigned x; volatile LAS unsigned* st; };
__device__ __forceinline__ XcdBarrier xcd_barrier_post(unsigned* bar, volatile LAS unsigned* st) {
    XcdBarrier b; b.bar = bar; b.x = xb_xcc_id(); b.st = st;
    if (threadIdx.x == 0) (void)xb_add(&bar[XB_XCNT(b.x)], 1u);
    return b;
}
__device__ __forceinline__ void xcd_barrier_complete(unsigned* bar, unsigned x, unsigned& nloc, unsigned& nx) {
    const unsigned G = gridDim.x * gridDim.y * gridDim.z;
    unsigned sum, cnt, mine, sp = 0u;
    for (;;) {
        sum = 0u; cnt = 0u; mine = 0u;
#pragma unroll
        for (unsigned j = 0; j < 16; ++j) { const unsigned c = xb_ld(&bar[XB_XCNT(j)]); sum += c; cnt += (c > 0u) ? 1u : 0u; mine = (j == x) ? c : mine; }
        if (sum == G) break;
        __builtin_amdgcn_s_sleep(1);
        if ((++sp & 255u) == 0u) { if (xb_ld(&bar[XB_TMO])) break; if (sp > XB_SPIN_CAP) { atomicAdd(&bar[XB_TMO], 1u); break; } }
    }
    nloc = mine > 0u ? mine : 1u; nx = cnt > 0u ? cnt : 1u;
}
__device__ __forceinline__ void xcd_barrier(const XcdBarrier& b) {
    asm volatile("s_waitcnt vmcnt(0)" ::: "memory");
    __syncthreads();
    if (threadIdx.x == 0) {
        unsigned* bar = b.bar;
        __builtin_amdgcn_s_waitcnt(0);
        unsigned nloc = b.st[0], nx = b.st[1];
        if (nloc == 0u) { xcd_barrier_complete(bar, b.x, nloc, nx); b.st[0] = nloc; b.st[1] = nx; }
        const unsigned old = xb_add(&bar[XB_XSUB(b.x)], 1u);
        const unsigned gen = old / nloc;
        if (old + 1u == (gen + 1u) * nloc) {
            __builtin_amdgcn_fence(__ATOMIC_RELEASE, "agent");
            asm volatile("s_waitcnt vmcnt(0)" ::: "memory");
            const unsigned og = xb_add(&bar[XB_TOP], 1u);
            const unsigned tg = og / nx;
            if (og + 1u == (tg + 1u) * nx) xb_add(&bar[XB_TOPGEN], 1u);
            else XB_SPIN(xb_ld(&bar[XB_TOPGEN]) == tg, bar);
            __builtin_amdgcn_fence(__ATOMIC_ACQUIRE, "agent");
            xb_add(&bar[XB_XGEN(b.x)], 1u);
            asm volatile("s_waitcnt vmcnt(0)" ::: "memory");
        } else {
            XB_SPIN(xb_ld(&bar[XB_XGEN(b.x)]) == gen, bar);
            __builtin_amdgcn_fence(__ATOMIC_ACQUIRE, "agent");
            asm volatile("s_waitcnt vmcnt(0)" ::: "memory");
        }
    }
    __syncthreads();
}

__device__ __forceinline__ const float* inptr(int i) { const float* const* ka = (const float* const*)__builtin_amdgcn_kernarg_segment_ptr(); asm volatile("" : "+s"(i)); return ka[i]; }
struct Frame {
    LAS unsigned char* lds; unsigned char* ldsg;
    volatile LAS unsigned* MISC;
    gu32* ctl;
    int tid, lane, wave, bid, G;
    unsigned char* ws;
};

__device__ __forceinline__ float wave_sum(float v) {
#pragma unroll
    for (int o = 1; o < 64; o <<= 1) v += __shfl_xor(v, o);
    return v;
}

__device__ __forceinline__ void p0_transpose_item(const float* W, int ldsrc, int k0s, int c0s, bf16* WT, int ldd, int n0, int k0d, bool permq, LAS float* scr, int lane) {
    const int j = lane & 31; const int pos = permq ? (8 * ((j >> 2) & 3) + 4 * (j >> 4) + (j & 3)) : j;
#pragma unroll 8
    for (int i = 0; i < 32; ++i) { const int kk = 2 * i + (lane >> 5); scr[kk * 33 + pos] = W[(size_t)(k0s + kk) * ldsrc + c0s + j]; }
    LDS_WAIT(); asm volatile("" ::: "memory");
    const int c = lane & 7;
#pragma unroll
    for (int jj = 0; jj < 4; ++jj) { const int n = (lane >> 3) + 8 * jj; const LAS float* s = scr + (8 * c) * 33 + n;
        v4u o; o.x = pk2(s[0 * 33], s[1 * 33]); o.y = pk2(s[2 * 33], s[3 * 33]); o.z = pk2(s[4 * 33], s[5 * 33]); o.w = pk2(s[6 * 33], s[7 * 33]);
        *(GAS v4u*)(WT + (size_t)(n0 + n) * ldd + k0d + 8 * c) = o; }
    LDS_WAIT(); asm volatile("" ::: "memory");
}
__device__ __forceinline__ void p0a(Frame& F) {
    bf16* const AWS_ = (bf16*)(F.ws + WS_AWS); bf16* const LRUW_ = (bf16*)(F.ws + WS_LRUW); bf16* const WIN_ = (bf16*)(F.ws + WS_WIN); bf16* const WO_ = (bf16*)(F.ws + WS_WO); const float* const a_ws_ = inptr(9); const float* const b_ada_ = inptr(5); const float* const c_ = inptr(1); const float* const cctx_ = inptr(3); const float* const lru_wi_ = inptr(17); const float* const lru_wr_ = inptr(15); float* const mods_ = (float*)(F.ws + WS_MODS); float* const rope_ = (float*)(F.ws + WS_ROPE); const float* const w_ada_ = inptr(4); const float* const w_in_ = inptr(6); const float* const w_o_ = inptr(20);
    int tid_ = threadIdx.x; asm volatile("" : "+v"(tid_)); const int tid = tid_, lane = tid & 63, wave = __builtin_amdgcn_readfirstlane(tid >> 6); (void)tid; (void)lane; (void)wave;
    {
        LAS float* sS = (LAS float*)F.lds; LAS float* red = (LAS float*)(F.lds + 17 * 1024 * 4);
        bool filled = false;
        for (int it = F.bid; it < DEPTH * 48; it += F.G) {
            const int l = it / 48, cb = it % 48;
            if (!filled) { for (int idx = tid; idx < 17 * 1024; idx += 512) { const int r = idx >> 10, k = idx & 1023; const float cv = r < 16 ? c_[r * 1024 + k] : cctx_[k]; sS[idx] = cv / (1.f + expf(-cv)); } filled = true; }
            __syncthreads();
            float acc[17];
#pragma unroll
            for (int r = 0; r < 17; ++r) acc[r] = 0.f;
            const float* wp = w_ada_ + ((size_t)l * 1024 + 128 * wave) * 3072 + 64 * cb + lane;
#pragma unroll 4
            for (int k = 0; k < 128; ++k) { const float wv = wp[(size_t)k * 3072];
#pragma unroll
                for (int r = 0; r < 17; ++r) acc[r] += sS[r * 1024 + 128 * wave + k] * wv; }
#pragma unroll
            for (int r = 0; r < 17; ++r) red[(wave * 17 + r) * 64 + lane] = acc[r];
            __syncthreads();
            for (int idx = tid; idx < 17 * 64; idx += 512) { const int r = idx >> 6, ln = idx & 63; float s = b_ada_[l * 3072 + 64 * cb + ln];
#pragma unroll
                for (int w = 0; w < 8; ++w) s += red[(w * 17 + r) * 64 + ln];
                mods_[((size_t)l * 17 + r) * 3072 + 64 * cb + ln] = s; }
            __syncthreads();
        }
    }
    if (F.bid == F.G - 1) {
        for (int idx = tid; idx < 1024; idx += 512) { const int pos = idx >> 4, i = idx & 15;
            const float inv = exp2f(-(float)i * (13.287712379549449f / 16.f)); const float ang = (float)pos * inv;
            const float kq = rintf(ang * 0.15915494309189535f); float rr = fmaf(-kq, 6.2831854820251465f, ang); rr = fmaf(-kq, -1.7484556e-7f, rr);
            rope_[idx] = __cosf(rr); rope_[1024 + idx] = __sinf(rr); }
    }
    __syncthreads();
    {
        LAS float* scr = (LAS float*)(F.lds + wave * 16384);
        const int gw = F.bid * NWAVES + wave, NGW = F.G * NWAVES;
        constexpr int I_IN = 16 * 80, I_O = 20 * 32;
        for (int it = gw; it < DEPTH * (I_IN + I_O); it += NGW) {
            const int l = it / (I_IN + I_O); int r = it % (I_IN + I_O);
            if (r < I_IN) {
                const int kb = r / 80, grp = r % 80;
                const int pn = grp >> 3, bj = (grp >> 2) & 1, wc = grp & 3;
                int lbase; bool pq = false;
                if (pn == 3 || pn == 4) { lbase = 768 + 64 * (wc + 4 * (pn - 3)) + 32 * bj; pq = true; }
                else if (pn == 5) { if (wc < 2) { lbase = 1280 + 64 * wc + 32 * bj; pq = true; } else lbase = 1408 + 64 * (wc - 2) + 32 * bj; }
                else { const int lb[10] = {0, 256, 512, 0, 0, 0, 1536, 1792, 2048, 2304}; lbase = lb[pn] + 128 * bj + 32 * wc; }
                p0_transpose_item(w_in_ + (size_t)l * DMODEL * DIN, DIN, 64 * kb, lbase, WIN_ + (size_t)l * DIN * DMODEL, DMODEL, 32 * grp, 64 * kb, pq, scr, lane);
            } else {
                r -= I_IN; const int kb = r / 32, nb = r % 32; const int k0d = 64 * kb, k0s = k0d < 1024 ? k0d : k0d - 256;
                p0_transpose_item(w_o_ + (size_t)l * DMODEL * DMODEL, DMODEL, k0s, 32 * nb, WO_ + (size_t)l * DMODEL * K2, K2, 32 * nb, k0d, false, scr, lane);
            }
        }
    }
    {
        const int gt = F.bid * 512 + tid, NT_ = F.G * 512;
        for (int i = gt; i < DEPTH * 4 * 128 * 128 / 4; i += NT_) { const f32x4 v = *(const f32x4*)(a_ws_ + (size_t)i * 4); v2u o; o.x = pk2(v[0], v[1]); o.y = pk2(v[2], v[3]); *(v2u*)(AWS_ + (size_t)i * 4) = o; }
        for (int i = gt; i < DEPTH * 2 * 4 * 2 * 2 * 4 * 64; i += NT_) {
            const int ln = i & 63, s = (i >> 6) & 3, nt = (i >> 8) & 1, g = (i >> 9) & 1, j = (i >> 10) & 3, d = (i >> 12) & 1, l = i >> 13;
            const float* w = (g == 0 ? lru_wr_ : lru_wi_) + ((size_t)((l * 2 + d) * 4 + j) * 64) * 64;
            const int col = 32 * nt + (ln & 31), i0 = 16 * s + 8 * (ln >> 5);
            v4u o; o.x = pk2(w[(i0 + 0) * 64 + col], w[(i0 + 1) * 64 + col]); o.y = pk2(w[(i0 + 2) * 64 + col], w[(i0 + 3) * 64 + col]);
            o.z = pk2(w[(i0 + 4) * 64 + col], w[(i0 + 5) * 64 + col]); o.w = pk2(w[(i0 + 6) * 64 + col], w[(i0 + 7) * 64 + col]);
            *(v4u*)(LRUW_ + (size_t)i * 8) = o; }
    }
}
__device__ __forceinline__ void p0b(Frame& F) {
    bf16* const XM_ = (bf16*)(F.ws + WS_XM); const float* const ctx_ = inptr(2); float* const mods_ = (float*)(F.ws + WS_MODS); const float* const x_ = inptr(0);
    int tid_ = threadIdx.x; asm volatile("" : "+v"(tid_)); const int tid = tid_, lane = tid & 63, wave = __builtin_amdgcn_readfirstlane(tid >> 6); (void)tid; (void)lane; (void)wave;
    const int gw = F.bid * NWAVES + wave, NGW = F.G * NWAVES;
    for (int m = gw; m < MROWS; m += NGW) {
        const float* src = m < NLAT ? x_ + (size_t)m * DMODEL : ctx_ + (size_t)(m - NLAT) * DMODEL; const int mrow = m < NLAT ? (m >> 11) : 16;
        const float* md = mods_ + (size_t)mrow * 3072;
        GAS v2u* o8 = (GAS v2u*)(XM_ + (size_t)m * DMODEL) + lane;
#pragma unroll
        for (int j = 0; j < 4; ++j) { const int k = 4 * lane + 256 * j; const f32x4 v = *(const f32x4*)(src + k), sh = *(const f32x4*)(md + k), sc = *(const f32x4*)(md + 1024 + k);
            const f32x4 o = v * (sc + 1.0f) + sh; v2u w; w.x = pk2(o[0], o[1]); w.y = pk2(o[2], o[3]); o8[64 * j] = w; }
    }
}
__device__ __forceinline__ void p4_ln(Frame& F, int l) {
    bf16* const XM_ = (bf16*)(F.ws + WS_XM); float* const XT_ = (float*)(F.ws + WS_XT); const float* const ln_b_ = inptr(22); const float* const ln_g_ = inptr(21); float* const mods_ = (float*)(F.ws + WS_MODS); float* const out_ = (float*)inptr(23);
    int tid_ = threadIdx.x; asm volatile("" : "+v"(tid_)); const int tid = tid_, lane = tid & 63, wave = __builtin_amdgcn_readfirstlane(tid >> 6); (void)tid; (void)lane; (void)wave;
    const int gw = F.bid * NWAVES + wave, NGW = F.G * NWAVES; const bool last = (l == DEPTH - 1); const int mend = last ? NLAT : MROWS;
    const float* lg = ln_g_ + l * DMODEL; const float* lb = ln_b_ + l * DMODEL;
    for (int m = gw; m < mend; m += NGW) {
        float* row = XT_ + (size_t)m * DMODEL; f32x4 v[4]; float s = 0.f;
#pragma unroll
        for (int j = 0; j < 4; ++j) { v[j] = *(const f32x4*)(row + 4 * lane + 256 * j); s += (v[j][0] + v[j][1]) + (v[j][2] + v[j][3]); }
        const float mean = wave_sum(s) * (1.f / DMODEL); float s2 = 0.f;
#pragma unroll
        for (int j = 0; j < 4; ++j) { v[j] = v[j] - mean; s2 += (v[j][0] * v[j][0] + v[j][1] * v[j][1]) + (v[j][2] * v[j][2] + v[j][3] * v[j][3]); }
        const float rstd = 1.f / sqrtf(wave_sum(s2) * (1.f / DMODEL) + 1e-6f);
        const int mrow = m < NLAT ? (m >> 11) : 16; const float* md = mods_ + ((size_t)(l + 1) * 17 + mrow) * 3072;
        GAS v2u* o8 = (GAS v2u*)(XM_ + (size_t)m * DMODEL) + lane;
#pragma unroll
        for (int j = 0; j < 4; ++j) { const int k = 4 * lane + 256 * j; const f32x4 o = v[j] * rstd * *(const f32x4*)(lg + k) + *(const f32x4*)(lb + k);
            if (last) { *(f32x4*)(out_ + (size_t)m * DMODEL + k) = o; }
            else { *(f32x4*)(row + k) = o; const f32x4 sh = *(const f32x4*)(md + k), sc = *(const f32x4*)(md + 1024 + k); const f32x4 xm = o * (sc + 1.0f) + sh;
                v2u w; w.x = pk2(xm[0], xm[1]); w.y = pk2(xm[2], xm[3]); o8[64 * j] = w; } }
    }
}
__device__ __forceinline__ void gmlp_unit(Frame& F, int l, int chunk) {
    bf16* const AWS_ = (bf16*)(F.ws + WS_AWS); bf16* const Z_ = (bf16*)(F.ws + WS_Z); const float* const a_bs_ = inptr(10); const float* const a_norm_b_ = inptr(8); const float* const a_norm_g_ = inptr(7);
    int tid_ = threadIdx.x; asm volatile("" : "+v"(tid_)); const int tid = tid_, lane = tid & 63, wave = __builtin_amdgcn_readfirstlane(tid >> 6); (void)tid; (void)lane; (void)wave; const int R0 = chunk * 128;
    constexpr int VP = 136;
    LAS bf16* VnT = (LAS bf16*)F.lds;
    {
        const int l5 = lane & 31, half = lane >> 5; const float* ng = a_norm_g_ + l * 256 + 8 * l5; const float* nb = a_norm_b_ + l * 256 + 8 * l5;
        const f32x4 g0 = *(const f32x4*)ng, g1 = *(const f32x4*)(ng + 4), b0 = *(const f32x4*)nb, b1 = *(const f32x4*)(nb + 4);
#pragma unroll 2
        for (int i = 0; i < 8; ++i) { const int tok = 16 * wave + 2 * i + half;
            const v4u raw = *(const v4u*)(Z_ + (size_t)(R0 + tok) * ZP + C_VA + 8 * l5);
            float v[8]; v[0] = bflo(raw.x); v[1] = bfhi(raw.x); v[2] = bflo(raw.y); v[3] = bfhi(raw.y); v[4] = bflo(raw.z); v[5] = bfhi(raw.z); v[6] = bflo(raw.w); v[7] = bfhi(raw.w);
            float s = ((v[0] + v[1]) + (v[2] + v[3])) + ((v[4] + v[5]) + (v[6] + v[7]));
#pragma unroll
            for (int o = 1; o < 32; o <<= 1) s += __shfl_xor(s, o);
            const float mu = s * (1.f / 256.f); float q = 0.f;
#pragma unroll
            for (int c = 0; c < 8; ++c) { v[c] -= mu; q += v[c] * v[c]; }
#pragma unroll
            for (int o = 1; o < 32; o <<= 1) q += __shfl_xor(q, o);
            const float rstd = 1.f / sqrtf(q * (1.f / 256.f) + 1e-6f);
#pragma unroll
            for (int c = 0; c < 8; ++c) { const float gg = c < 4 ? g0[c & 3] : g1[c & 3], bb = c < 4 ? b0[c & 3] : b1[c & 3]; VnT[(8 * l5 + c) * VP + tok] = (bf16)f2bf(v[c] * rstd * gg + bb); }
        }
    }
    __syncthreads();
    const int g = wave >> 1, ph = wave & 1, r32 = lane & 31, hi = lane >> 5;
    f32x16 acc[2][2];
#pragma unroll
    for (int a = 0; a < 2; ++a)
#pragma unroll
        for (int b = 0; b < 2; ++b)
#pragma unroll
            for (int e = 0; e < 16; ++e) acc[a][b][e] = 0.f;
    {
        const bf16* A0 = AWS_ + ((size_t)(l * 4 + g) * 128 + 64 * ph + r32) * 128 + 8 * hi;
        const LAS bf16* B0 = VnT + (64 * g + r32) * VP + 8 * hi;
#pragma unroll
        for (int s = 0; s < 8; ++s) {
            bf16x8 a[2], b[2];
#pragma unroll
            for (int mt = 0; mt < 2; ++mt) a[mt] = *(const bf16x8*)(A0 + mt * 32 * 128 + 16 * s);
#pragma unroll
            for (int nt = 0; nt < 2; ++nt) b[nt] = *(const LAS bf16x8*)(B0 + nt * 32 * VP + 16 * s);
#pragma unroll
            for (int mt = 0; mt < 2; ++mt)
#pragma unroll
                for (int nt = 0; nt < 2; ++nt) acc[mt][nt] = __builtin_amdgcn_mfma_f32_32x32x16_bf16(a[mt], b[nt], acc[mt][nt], 0, 0, 0);
        }
    }
    const float* bs = a_bs_ + (l * 4 + g) * 128;
#pragma unroll
    for (int mt = 0; mt < 2; ++mt)
#pragma unroll
        for (int reg = 0; reg < 16; ++reg) { const int p = 64 * ph + 32 * mt + crow16(reg, hi); const float bsv = bs[p]; bf16* zp = Z_ + (size_t)(R0 + p) * ZP + 64 * g + r32;
#pragma unroll
            for (int nt = 0; nt < 2; ++nt) { const float u = bf1(zp[C_MA + 32 * nt]), ga = bf1(zp[C_GA + 32 * nt]); zp[C_MA + 32 * nt] = (bf16)f2bf(u * (acc[mt][nt][reg] + bsv) * ga); } }
}
__device__ __forceinline__ void lru_unit(Frame& F, int l, int b, int u) {
    bf16* const LRUW_ = (bf16*)(F.ws + WS_LRUW); bf16* const XR_ = (bf16*)(F.ws + WS_XR); bf16* const Z_ = (bf16*)(F.ws + WS_Z); const float* const conv_b_ = inptr(14); const float* const conv_w_ = inptr(13); const float* const lru_bi_ = inptr(18); const float* const lru_br_ = inptr(16); const float* const lru_lam_ = inptr(19);
    int tid_ = threadIdx.x; asm volatile("" : "+v"(tid_)); const int tid = tid_, lane = tid & 63, wave = __builtin_amdgcn_readfirstlane(tid >> 6); (void)tid; (void)lane; (void)wave;
    {
        const int c8 = tid & 15, tr = tid >> 4; const int ch = 128 * u + 8 * c8;
        f32x4 w0[4], w1[4];
#pragma unroll
        for (int tap = 0; tap < 4; ++tap) { w0[tap] = *(const f32x4*)(conv_w_ + (l * 4 + tap) * 256 + ch); w1[tap] = *(const f32x4*)(conv_w_ + (l * 4 + tap) * 256 + ch + 4); }
        const f32x4 cb0 = *(const f32x4*)(conv_b_ + l * 256 + ch), cb1 = *(const f32x4*)(conv_b_ + l * 256 + ch + 4);
#pragma unroll 1
        for (int seg = 0; seg < 2; ++seg) { const int rowbase = seg ? b * SEQ : NLAT + b * CTXL, L = seg ? SEQ : CTXL, per = L >> 5;
#pragma unroll 1
            for (int tt = 0; tt < per; ++tt) { const int t = tr * per + tt; f32x4 y0 = cb0, y1 = cb1;
#pragma unroll
                for (int tap = 0; tap < 4; ++tap) { const int ts = t + tap - 2;
                    if (ts >= 0 && ts < L) { const v4u raw = *(const v4u*)(Z_ + (size_t)(rowbase + ts) * ZP + C_RX + ch);
                        y0 += w0[tap] * (f32x4){bflo(raw.x), bfhi(raw.x), bflo(raw.y), bfhi(raw.y)}; y1 += w1[tap] * (f32x4){bflo(raw.z), bfhi(raw.z), bflo(raw.w), bfhi(raw.w)}; } }
                v4u o; o.x = pk2(y0[0], y0[1]); o.y = pk2(y0[2], y0[3]); o.z = pk2(y1[0], y1[1]); o.w = pk2(y1[2], y1[3]);
                *(v4u*)(XR_ + (size_t)(rowbase + t) * 256 + ch) = o; } }
    }
    VM_WAIT(); __syncthreads();
    const int jj = __builtin_amdgcn_readfirstlane(wave >> 2), d = __builtin_amdgcn_readfirstlane((wave >> 1) & 1), nt = __builtin_amdgcn_readfirstlane(wave & 1);
    const int j = 2 * u + jj, r32 = lane & 31, hi = lane >> 5; const int c = 64 * j + 32 * nt + r32;
    bf16x8 Wr[4], Wi[4], Id[4];
    { const bf16* lw = LRUW_ + ((size_t)((((l * 2 + d) * 4 + j) * 2 + 0) * 2 + nt) * 4) * 64 * 8;
#pragma unroll
      for (int s = 0; s < 4; ++s) { Wr[s] = *(const bf16x8*)(lw + (s * 64 + lane) * 8); Wi[s] = *(const bf16x8*)(lw + 2 * 4 * 64 * 8 + (s * 64 + lane) * 8);
#pragma unroll
          for (int e = 0; e < 8; ++e) Id[s][e] = (16 * s + 8 * hi + e == 32 * nt + r32) ? (short)0x3F80 : (short)0; } }
    const float brv = lru_br_[(l * 2 + d) * 256 + c], biv = lru_bi_[(l * 2 + d) * 256 + c];
    const float lam = lru_lam_[(l * 2 + d) * 256 + c]; const float ka = 8.0f * 1.4426950408889634f * log1pf(expf(-lam));
    const int ocol = (d ? C_HB : C_HF) + c;
    float carry = 0.f;
#pragma unroll 1
    for (int seg = 0; seg < 2; ++seg) { const int rowbase = seg ? b * SEQ : NLAT + b * CTXL, ntile = (seg ? SEQ : CTXL) >> 5;
#pragma unroll 1
        for (int ti = 0; ti < ntile; ++ti) { const int t0 = 32 * (d ? ntile - 1 - ti : ti);
            const bf16* ap = XR_ + (size_t)(rowbase + t0 + r32) * 256 + 64 * j + 8 * hi;
            bf16x8 A[4];
#pragma unroll
            for (int s = 0; s < 4; ++s) A[s] = *(const bf16x8*)(ap + 16 * s);
            f32x16 ar, ai, ax;
#pragma unroll
            for (int e = 0; e < 16; ++e) { ar[e] = 0.f; ai[e] = 0.f; ax[e] = 0.f; }
#pragma unroll
            for (int s = 0; s < 4; ++s) { ar = __builtin_amdgcn_mfma_f32_32x32x16_bf16(A[s], Wr[s], ar, 0, 0, 0); ai = __builtin_amdgcn_mfma_f32_32x32x16_bf16(A[s], Wi[s], ai, 0, 0, 0);
                ax = __builtin_amdgcn_mfma_f32_32x32x16_bf16(A[s], Id[s], ax, 0, 0, 0); }
            float av[16], bx[16];
#pragma unroll
            for (int e = 0; e < 16; ++e) { const float rr = __builtin_amdgcn_rcpf(1.f + __builtin_amdgcn_exp2f(-1.4426950408889634f * (ar[e] + brv)));
                const float ii = __builtin_amdgcn_rcpf(1.f + __builtin_amdgcn_exp2f(-1.4426950408889634f * (ai[e] + biv)));
                const float a = __builtin_amdgcn_exp2f(-ka * rr); av[e] = a; bx[e] = __builtin_amdgcn_sqrtf(fmaxf(1.f - a * a, 0.f)) * ii * ax[e]; }
            float hl[16], pl[16], Pk[4], Sk[4];
            if (d == 0) {
#pragma unroll
                for (int k = 0; k < 4; ++k) { float S = 0.f, P = 1.f;
#pragma unroll
                    for (int e = 0; e < 4; ++e) { const int i = 4 * k + e; S = av[i] * S + bx[i]; P *= av[i]; hl[i] = S; pl[i] = P; } Pk[k] = P; Sk[k] = S; }
            } else {
#pragma unroll
                for (int k = 0; k < 4; ++k) { float S = 0.f, P = 1.f;
#pragma unroll
                    for (int e = 3; e >= 0; --e) { const int i = 4 * k + e; S = av[i] * S + bx[i]; P *= av[i]; hl[i] = S; pl[i] = P; } Pk[k] = P; Sk[k] = S; }
            }
            float cin[4]; float cc = carry;
            if (d == 0) {
#pragma unroll
                for (int k = 0; k < 4; ++k) { const float Pp = __shfl_xor(Pk[k], 32), Sp = __shfl_xor(Sk[k], 32);
                    const float P0 = hi ? Pp : Pk[k], S0 = hi ? Sp : Sk[k], P1 = hi ? Pk[k] : Pp, S1 = hi ? Sk[k] : Sp;
                    const float c0 = cc; cc = P0 * cc + S0; const float c1 = cc; cc = P1 * cc + S1; cin[k] = hi ? c1 : c0; }
            } else {
#pragma unroll
                for (int k = 3; k >= 0; --k) { const float Pp = __shfl_xor(Pk[k], 32), Sp = __shfl_xor(Sk[k], 32);
                    const float P0 = hi ? Pp : Pk[k], S0 = hi ? Sp : Sk[k], P1 = hi ? Pk[k] : Pp, S1 = hi ? Sk[k] : Sp;
                    const float c1 = cc; cc = P1 * cc + S1; const float c0 = cc; cc = P0 * cc + S0; cin[k] = hi ? c1 : c0; }
            }
            carry = cc;
            bf16* zp = Z_ + (size_t)(rowbase + t0 + 4 * hi) * ZP;
#pragma unroll
            for (int e = 0; e < 16; ++e) { bf16* zr = zp + (size_t)((e & 3) + 8 * (e >> 2)) * ZP; const float h = hl[e] + pl[e] * cin[e >> 2]; zr[ocol] = (bf16)f2bf(h * bf1(zr[C_RG + c])); }
        }
    }
}

struct Args { const float* in[23]; float* out; unsigned char* ws; int ph_lo, ph_hi; };
__global__ void __launch_bounds__(NWAVES * 64, 2) mk_fwd(Args args) {
    extern __shared__ __attribute__((aligned(16))) unsigned char lds[];
    Frame F;
    F.lds = (LAS unsigned char*)lds; F.ldsg = lds;
    F.MISC = (volatile LAS unsigned*)(F.lds + MISC_OFF);
    F.tid = threadIdx.x; F.lane = F.tid & 63; F.wave = __builtin_amdgcn_readfirstlane(F.tid >> 6);
    F.G = gridDim.x; F.bid = blockIdx.x;
    unsigned char* ws = args.ws;
    F.ws = ws; F.ctl = (gu32*)(ws + WS_CTL);
    for (int u = F.tid; u < (LDS_BYTES - LDSCTL_OFF) / 4; u += NWAVES * 64) ((LAS unsigned*)(F.lds + LDSCTL_OFF))[u] = 0u;
    __syncthreads();
    XcdBarrier bar; bar.bar = (unsigned*)(F.ctl + CW_BAR); bar.x = 0; bar.st = nullptr;
    const int lo = args.ph_lo, hi = args.ph_hi;
    if (hi - lo > 1) bar = xcd_barrier_post((unsigned*)(F.ctl + CW_BAR), F.MISC + 8);
#define IN(k) (lo <= (k) && (k) < hi)
#define SEAM(k) do { if (IN(k) && IN((k) + 1)) xcd_barrier(bar); } while (0)

    if (IN(0)) { p0a(F); SEAM(0); }
    if (IN(1)) { p0b(F); SEAM(1); }
#pragma unroll 1
    for (int l = 0; l < DEPTH; ++l) {
        const int pb = 2 + 4 * l; const bool last = (l == DEPTH - 1);
        if (IN(pb)) {
            pg8::Gemm g{(const bf16*)(ws + WS_XM), (const bf16*)(ws + WS_WIN) + (size_t)l * DIN * DMODEL, MROWS, DIN, DMODEL, DMODEL}; pg8::StaticOrder S; S.init(MROWS, DIN, F.G, F.bid);
            pg8::Epi1 E{(bf16*)(ws + WS_Z), inptr(11) + l * 64, inptr(12) + l * 64, (const float*)(ws + WS_ROPE)};
            pg8::gemm_phase<pg8::Epi1, pg8::StaticOrder, true, true>(F.lds + RING_OFF, g, S, E);
            SEAM(pb);
        }
        if (IN(pb + 1)) {
            const int n_attc = last ? 0 : 128, n_g = last ? 256 : 288; const int o_attl = 32, o_attc = o_attl + 1024, o_g = o_attc + n_attc, total = o_g + n_g;
            gu32* head = F.ctl + CW_Q + 64 * l;
            for (;;) {
                if (F.tid == 0) F.MISC[0] = __hip_atomic_fetch_add((unsigned*)head, 1u, RLX_AGENT);
                __syncthreads(); const int unit = (int)F.MISC[0]; __syncthreads();
                if (unit >= total) break;
                if (unit < o_attl) lru_unit(F, l, unit >> 1, unit & 1);
                else if (unit < o_attc) { const int a = unit - o_attl; const int b = a >> 6, kvh = (a >> 5) & 1, qb = (a >> 2) & 7, h = kvh * 4 + (a & 3);
                    const attn_body::bf16* Zb = (const attn_body::bf16*)(ws + WS_Z);
                    attn_body::attn_unit<8>(Zb + (size_t)(b * SEQ + qb * 256) * ZP + C_Q + h * 64, Zb + (size_t)(b * SEQ) * ZP + C_K + kvh * 64, Zb + (size_t)(NLAT + b * CTXL) * ZP + C_K + kvh * 64, 32, 36, (char*)F.ldsg + RING_OFF); }
                else if (unit < o_g) { const int a = unit - o_attc; const int b = a >> 3, h = a & 7;
                    const attn_body::bf16* Zb = (const attn_body::bf16*)(ws + WS_Z); const attn_body::bf16* kc = Zb + (size_t)(NLAT + b * CTXL) * ZP + C_K + (h >> 2) * 64;
                    attn_body::attn_unit<8>(Zb + (size_t)(NLAT + b * CTXL) * ZP + C_Q + h * 64, kc, kc, 4, 4, (char*)F.ldsg + RING_OFF); }
                else gmlp_unit(F, l, unit - o_g);
            }
            SEAM(pb + 1);
        }
        if (IN(pb + 2)) {
            const int M3 = last ? NLAT : MROWS;
            pg8::Gemm g{(const bf16*)(ws + WS_Z), (const bf16*)(ws + WS_WO) + (size_t)l * DMODEL * K2, M3, DMODEL, K2, ZP}; pg8::StaticOrder S; S.init(M3, DMODEL, F.G, F.bid);
            pg8::Epi2 E{inptr(0), inptr(2), (float*)(ws + WS_XT), (const float*)(ws + WS_MODS) + (size_t)l * 17 * 3072, l == 0 ? 1 : 0};
            pg8::gemm_phase<pg8::Epi2, pg8::StaticOrder, true, true>(F.lds + RING_OFF, g, S, E);
            SEAM(pb + 2);
        }
        if (IN(pb + 3)) { p4_ln(F, l); SEAM(pb + 3); }
    }
#undef IN
#undef SEAM
}

extern "C" void kernel_launch(void* const* d_in, const int* in_sizes, int n_in, void* d_out, int out_size, void* d_ws, size_t ws_size, hipStream_t stream) {
    static int grid = 0;
    if (grid == 0) {
        if (n_in != 23 || out_size != NLAT * DMODEL || ws_size < WS_END) { fprintf(stderr, "kernel_launch: unexpected shapes (n_in %d out %d ws %zu, need %zu); nothing launched\n", n_in, out_size, ws_size, (size_t)WS_END); grid = -1; return; }
        int dev = 0, cus = 0;
        if (hipGetDevice(&dev) != hipSuccess || hipDeviceGetAttribute(&cus, hipDeviceAttributeMultiprocessorCount, dev) != hipSuccess) { grid = -1; return; }
        if (hipFuncSetAttribute((const void*)mk_fwd, hipFuncAttributeMaxDynamicSharedMemorySize, LDS_BYTES) != hipSuccess) { fprintf(stderr, "kernel_launch: hipFuncSetAttribute failed\n"); grid = -1; return; }
        int per_cu = 0; (void)hipOccupancyMaxActiveBlocksPerMultiprocessor(&per_cu, (const void*)mk_fwd, NWAVES * 64, LDS_BYTES); (void)hipGetLastError();
        grid = cus;
    }
    if (grid < 0) return;
    if (hipMemsetAsync((char*)d_ws + WS_CTL, 0, CTL_ZERO_BYTES, stream) != hipSuccess) return;
    Args a{};
    for (int i = 0; i < 23; ++i) a.in[i] = (const float*)d_in[i];
    a.out = (float*)d_out; a.ws = (unsigned char*)d_ws;
#if MK_PER_PHASE
    for (int p = 0; p < NPHASE; ++p) { a.ph_lo = p; a.ph_hi = p + 1; hipLaunchKernelGGL(mk_fwd, dim3(grid), dim3(NWAVES * 64), LDS_BYTES, stream, a); }
#else
    a.ph_lo = 0; a.ph_hi = NPHASE;
    hipLaunchKernelGGL(mk_fwd, dim3(grid), dim3(NWAVES * 64), LDS_BYTES, stream, a);
#endif
}
```

```cpp
#include <hip/hip_runtime.h>
#include <hip/hip_bf16.h>
#include <cstdio>
#include <cstdint>
#include <cmath>

constexpr int DMODEL = 1024, NBATCH = 16, SEQ = 2048, CTXL = 256, DEPTH = 4;
constexpr int NLAT = NBATCH * SEQ, NCTXR = NBATCH * CTXL, MROWS = NLAT + NCTXR;
constexpr int DIN = 2560;
constexpr int ZP = 3072;
constexpr int C_MA = 0, C_Q = 256, C_HF = 768, C_HB = 1024, C_VA = 1280, C_GA = 1536, C_K = 1792, C_V = 1920, C_GB = 2048, C_RX = 2560, C_RG = 2816;
constexpr int K2 = 1280;
constexpr float ALPHA = 1.681792830507429f;
constexpr float QSCALE = 0.125f * 1.4426950408889634f;

namespace pg8 {
#define PG8_LAS __attribute__((address_space(3)))
typedef unsigned short bf16_t;
typedef short bf16x8 __attribute__((ext_vector_type(8)));
typedef float f32x4 __attribute__((ext_vector_type(4)));
typedef unsigned u32x4 __attribute__((ext_vector_type(4)));
constexpr int BM = 256, BK = 64, HALF = 128, HTB = HALF * BK * 2, STAGE_BYTES = 8 * HTB, NXCD = 8, WGM = 8;

__host__ __device__ __forceinline__ int lds_byte(int r, int c) { const int st = (r >> 4) * 2 + (c >> 5), rr = r & 15, cc = c & 31, ob = rr * 64 + cc * 2; return st * 1024 + (ob ^ (((ob >> 9) & 1) << 5)); }
__host__ __device__ __forceinline__ void stage_rc(int b, int& R, int& C) { const int st = b / 1024, sb = b % 1024, swz = sb ^ (((sb >> 9) & 1) << 5); R = (st >> 1) * 16 + swz / 64; C = (st & 1) * 32 + (swz % 64) / 2; }
__host__ __device__ __forceinline__ int perm32(int rho) { const int n = rho >> 4, i = rho & 15; return 8 * (i >> 2) + 4 * n + (i & 3); }

struct Unit { int pm, pn; };
struct Gemm { const bf16_t* A; const bf16_t* Bt; int M, N, K, lda; };

struct StaticOrder {
    int nM, nN, nwg, G, c;
    __host__ __device__ void init(int M, int N, int G_, int c_) { nM = M / BM; nN = N / BM; nwg = nM * nN; G = G_; c = c_; }
    __host__ __device__ bool next(int i, Unit& u) const {
        const long L = (long)i * G + c; if (L >= nwg) return false;
        int wgid = (int)L; { const int q = nwg / NXCD, r = nwg % NXCD, xcd = wgid % NXCD, off = wgid / NXCD; wgid = (xcd < r ? xcd * (q + 1) : r * (q + 1) + (xcd - r) * q) + off; }
        const int nig = WGM * nN, gid = wgid / nig, fm = gid * WGM, gsz = (nM - fm) < WGM ? (nM - fm) : WGM;
        u.pm = fm + ((wgid % nig) % gsz); u.pn = (wgid % nig) / gsz; return true;
    }
    __device__ __forceinline__ void a_ready(const Unit&) const {}
    __device__ __forceinline__ void done(const Unit&) const {}
};

__device__ __forceinline__ unsigned cvt_pk_bf16(float lo, float hi) { unsigned r; asm volatile("v_cvt_pk_bf16_f32 %0, %1, %2" : "=v"(r) : "v"(lo), "v"(hi)); return r; }
__device__ __forceinline__ float fast_gelu(float x) {
    const float u = 0.7978845608028654f * (x + 0.044715f * x * x * x);
    return x * __builtin_amdgcn_rcpf(1.f + __builtin_amdgcn_exp2f(-2.8853900817779268f * u));
}
__device__ __forceinline__ float fast_silu(float x) { return x * __builtin_amdgcn_rcpf(1.f + __builtin_amdgcn_exp2f(-1.4426950408889634f * x)); }

struct Epi1 {
    static constexpr bool PERM = true, AFTER_DRAIN = false;
    bf16_t* Z; const float* qg; const float* kg; const float* rope;
    __device__ __forceinline__ void operator()(const f32x4 (&acc)[2][2][4][2], const Unit& u, int wr, int wc, int fr, int fq) const {
        asm volatile("" : "+v"(fr), "+v"(fq));
        const int pn = u.pn; const int row0 = u.pm * BM + wr * 64 + fr;
        const bool qk = (pn == 3) || (pn == 4) || (pn == 5 && wc < 2);
        if (qk) {
            const float* g = (pn == 5) ? kg : qg; const float sc = (pn == 5) ? 1.f : QSCALE;
            const int dst = (pn == 5) ? (C_K + wc * 64) : (C_Q + (wc + 4 * (pn - 3)) * 64);
            f32x4 gw[2][2];
#pragma unroll
            for (int bj = 0; bj < 2; ++bj)
#pragma unroll
                for (int n = 0; n < 2; ++n) gw[bj][n] = *(const f32x4*)(g + 32 * bj + 16 * n + 4 * fq) * sc;
            const bool lat = u.pm < 128;
#pragma unroll
            for (int ai = 0; ai < 2; ++ai)
#pragma unroll
                for (int m = 0; m < 4; ++m) {
                    const int r = row0 + ai * HALF + m * 16;
                    float ss = 0.f;
#pragma unroll
                    for (int bj = 0; bj < 2; ++bj)
#pragma unroll
                        for (int n = 0; n < 2; ++n) { const f32x4 x = acc[ai][bj][m][n]; ss += (x[0] * x[0] + x[1] * x[1]) + (x[2] * x[2] + x[3] * x[3]); }
                    ss += __shfl_xor(ss, 16); ss += __shfl_xor(ss, 32);
                    const float rms = __builtin_amdgcn_rsqf(ss * (1.f / 64.f) + 1e-6f);
                    const int t = r & 2047;
                    bf16_t* zr = Z + (size_t)r * ZP + dst + 8 * fq;
#pragma unroll
                    for (int bj = 0; bj < 2; ++bj) {
                        const f32x4 x1 = acc[ai][bj][m][0] * rms * gw[bj][0], x2 = acc[ai][bj][m][1] * rms * gw[bj][1];
                        f32x4 o1 = x1, o2 = x2;
                        if (lat) { const int pos = bj ? (t & 63) : (t >> 6);
                            const f32x4 cs = *(const f32x4*)(rope + pos * 16 + 4 * fq), sn = *(const f32x4*)(rope + 1024 + pos * 16 + 4 * fq);
                            o1 = x1 * cs - x2 * sn; o2 = x1 * sn + x2 * cs; }
                        u32x4 w; w.x = cvt_pk_bf16(o1[0], o1[1]); w.y = cvt_pk_bf16(o1[2], o1[3]); w.z = cvt_pk_bf16(o2[0], o2[1]); w.w = cvt_pk_bf16(o2[2], o2[3]);
                        *(u32x4*)(zr + 32 * bj) = w;
                    }
                    asm volatile("" ::: "memory");
                }
        } else {
            int zb = 0, act = 0, bstep = HALF;
            if (pn == 0) { zb = C_MA; act = 1; } else if (pn == 1) { zb = C_VA; act = 1; } else if (pn == 2) { zb = C_GA; act = 2; }
            else if (pn == 5) { zb = C_V + (wc - 2) * 64 - wc * 32; act = 0; bstep = 32; }
            else if (pn == 6) { zb = C_GB; act = 2; } else if (pn == 7) { zb = C_GB + 256; act = 2; } else if (pn == 8) { zb = C_RX; act = 0; } else { zb = C_RG; act = 2; }
            const int col0 = zb + wc * 32 + 8 * fq;
#pragma unroll
            for (int ai = 0; ai < 2; ++ai)
#pragma unroll
                for (int m = 0; m < 4; ++m) {
                    bf16_t* zr = Z + (size_t)(row0 + ai * HALF + m * 16) * ZP + col0;
#pragma unroll
                    for (int bj = 0; bj < 2; ++bj) {
                        f32x4 v0 = acc[ai][bj][m][0], v1 = acc[ai][bj][m][1];
                        if (act == 1) {
#pragma unroll
                            for (int e = 0; e < 4; ++e) { v0[e] = fast_gelu(v0[e]); v1[e] = fast_gelu(v1[e]); }
                        } else if (act == 2) {
#pragma unroll
                            for (int e = 0; e < 4; ++e) { v0[e] = fast_silu(v0[e]); v1[e] = fast_silu(v1[e]); }
                        }
                        u32x4 w; w.x = cvt_pk_bf16(v0[0], v0[1]); w.y = cvt_pk_bf16(v0[2], v0[3]); w.z = cvt_pk_bf16(v1[0], v1[1]); w.w = cvt_pk_bf16(v1[2], v1[3]);
                        *(u32x4*)(zr + bj * bstep) = w;
                    }
                }
        }
    }
};
struct Epi2 {
    static constexpr bool PERM = false, AFTER_DRAIN = false;
    const float* xin; const float* ctxin; float* XT; const float* mods_l; int layer0;
    __device__ __forceinline__ void operator()(const f32x4 (&acc)[2][2][4][2], const Unit& u, int wr, int wc, int fr, int fq) const {
        asm volatile("" : "+v"(fr), "+v"(fq));
        const int row0 = u.pm * BM + wr * 64 + fr, col0 = u.pn * BM + wc * 32 + 4 * fq;
        const int mrow = u.pm < 128 ? (u.pm >> 3) : 16;
        const float* gp = mods_l + mrow * 3072 + 2048 + col0;
        f32x4 gv[2][2];
#pragma unroll
        for (int bj = 0; bj < 2; ++bj)
#pragma unroll
            for (int n = 0; n < 2; ++n) gv[bj][n] = *(const f32x4*)(gp + bj * HALF + n * 16);
#pragma unroll
        for (int ai = 0; ai < 2; ++ai)
#pragma unroll
            for (int m = 0; m < 4; ++m) {
                const int r = row0 + ai * HALF + m * 16;
                const float* src = layer0 ? (r < NLAT ? xin + (size_t)r * DMODEL : ctxin + (size_t)(r - NLAT) * DMODEL) : XT + (size_t)r * DMODEL;
                float* dstp = XT + (size_t)r * DMODEL + col0; src += col0;
#pragma unroll
                for (int bj = 0; bj < 2; ++bj)
#pragma unroll
                    for (int n = 0; n < 2; ++n) { const f32x4 x = *(const f32x4*)(src + bj * HALF + n * 16); *(f32x4*)(dstp + bj * HALF + n * 16) = x * ALPHA + gv[bj][n] * acc[ai][bj][m][n]; }
                if (m & 1) asm volatile("" ::: "memory");
            }
    }
};
template <class Epi, class Sched, bool ALIGN_EPI = false, bool SP2 = false>
__device__ __forceinline__ void gemm_phase(PG8_LAS unsigned char* lds, const Gemm g, const Sched& S, const Epi& E) {
    int tid_ = threadIdx.x; asm volatile("" : "+v"(tid_));
    const int tid = tid_, wid = __builtin_amdgcn_readfirstlane(tid >> 6), lane = tid & 63, wr = wid >> 2, wc = wid & 3, fr = lane & 15, fq = lane >> 4;
    const int K = g.K, nt = K / BK;
    unsigned voffA[2], voffB[2];
#pragma unroll
    for (int i = 0; i < 2; ++i) { int R, C; stage_rc(tid * 16 + i * 8192, R, C); const int Rb = Epi::PERM ? ((R & ~31) + perm32(R & 31)) : R;
        voffA[i] = (unsigned)(R * g.lda + C) * 2u; voffB[i] = (unsigned)(Rb * K + C) * 2u; }
    const size_t kstep = (size_t)(BK * 2);
    const size_t hstepA = (size_t)HALF * g.lda * 2, hstepB = (size_t)HALF * K * 2;
    const size_t tstepA = 2 * hstepA, tstepB = 2 * hstepB;
    const unsigned ldsw = (unsigned)wid * 1024u;
    const int aoff = lds_byte(wr * 64 + fr, fq * 8), boff = lds_byte(wc * 32 + fr, fq * 8);
#define PG8_SA(b, h) (((b) * 2 + (h)) * HTB)
#define PG8_SB(b, h) ((4 + (b) * 2 + (h)) * HTB)
#define PG8_STAGE(bufoff, gbase, voff) do { _Pragma("unroll") for (int _i = 0; _i < 2; ++_i) \
        __builtin_amdgcn_global_load_lds((const unsigned*)((const char*)(gbase) + (voff)[_i]), (PG8_LAS unsigned*)(lds + (bufoff) + ldsw + _i * 8192), 16, 0, 0); } while (0)
#define PG8_LDA(dst, b, h) do { _Pragma("unroll") for (int m = 0; m < 4; ++m) _Pragma("unroll") for (int k = 0; k < 2; ++k) dst[m][k] = *(const PG8_LAS bf16x8*)(lds + PG8_SA(b, h) + aoff + m * 2048 + k * 1024); } while (0)
#define PG8_LDB(dst, b, h) do { _Pragma("unroll") for (int n = 0; n < 2; ++n) _Pragma("unroll") for (int k = 0; k < 2; ++k) dst[n][k] = *(const PG8_LAS bf16x8*)(lds + PG8_SB(b, h) + boff + n * 2048 + k * 1024); } while (0)
#define PG8_MMA(ai, bj, At, Bt) do { __builtin_amdgcn_s_setprio(1); _Pragma("unroll") for (int m = 0; m < 4; ++m) _Pragma("unroll") for (int n = 0; n < 2; ++n) _Pragma("unroll") for (int k = 0; k < 2; ++k) \
        acc[ai][bj][m][n] = __builtin_amdgcn_mfma_f32_16x16x32_bf16(Bt[n][k], At[m][k], acc[ai][bj][m][n], 0, 0, 0); __builtin_amdgcn_s_setprio(0); } while (0)
#define PG8_WAIT_V(n) asm volatile("s_waitcnt vmcnt(" #n ")" ::: "memory")
#define PG8_WAIT_L(n) asm volatile("s_waitcnt lgkmcnt(" #n ")" ::: "memory")
#define PG8_BAR __builtin_amdgcn_s_barrier()
#define PG8_SCHED __builtin_amdgcn_sched_barrier(0)
    Unit cur, nxt; int ui = 0;
    if (!S.next(0, cur)) return;
    f32x4 acc[2][2][4][2];
#pragma unroll
    for (int a = 0; a < 2; ++a)
#pragma unroll
        for (int b = 0; b < 2; ++b)
#pragma unroll
            for (int m = 0; m < 4; ++m)
#pragma unroll
                for (int n = 0; n < 2; ++n) acc[a][b][m][n] = (f32x4){0.f, 0.f, 0.f, 0.f};
    bf16x8 At[4][2], B0[2][2], B1[2][2];
    const char* cA = (const char*)g.A + (size_t)cur.pm * tstepA; const char* cB = (const char*)g.Bt + (size_t)cur.pn * tstepB;
    S.a_ready(cur);
    if constexpr (SP2) {
        PG8_STAGE(PG8_SB(0, 0), cB, voffB); PG8_STAGE(PG8_SB(0, 1), cB + hstepB, voffB); PG8_STAGE(PG8_SA(0, 0), cA, voffA); PG8_STAGE(PG8_SA(0, 1), cA + hstepA, voffA);
        if (wr == 1) PG8_BAR;
        PG8_WAIT_V(2); PG8_BAR;
        PG8_STAGE(PG8_SB(1, 0), cB + kstep, voffB); PG8_STAGE(PG8_SA(1, 0), cA + kstep, voffA); PG8_STAGE(PG8_SB(1, 1), cB + hstepB + kstep, voffB);
        PG8_WAIT_V(6); PG8_BAR;
    } else {
        PG8_STAGE(PG8_SB(0, 0), cB, voffB); PG8_STAGE(PG8_SA(0, 0), cA, voffA); PG8_STAGE(PG8_SB(0, 1), cB + hstepB, voffB); PG8_STAGE(PG8_SA(0, 1), cA + hstepA, voffA);
        if (wr == 1) PG8_BAR;
        PG8_WAIT_V(4); PG8_BAR;
        PG8_STAGE(PG8_SB(1, 0), cB + kstep, voffB); PG8_STAGE(PG8_SA(1, 0), cA + kstep, voffA); PG8_STAGE(PG8_SB(1, 1), cB + hstepB + kstep, voffB);
        PG8_WAIT_V(6); PG8_BAR;
    }
    for (;;) {
        const bool has_next = S.next(ui + 1, nxt);
        const char* nA = has_next ? (const char*)g.A + (size_t)nxt.pm * tstepA : cA; const char* nB = has_next ? (const char*)g.Bt + (size_t)nxt.pn * tstepB : cB;
        for (int t = 0; t < nt; t += 2) {
            const bool last = (t == nt - 2);
            const char* a1 = cA + (size_t)(t + 1) * kstep;
            const char* a2 = last ? nA : cA + (size_t)(t + 2) * kstep; const char* b2 = last ? nB : cB + (size_t)(t + 2) * kstep;
            const char* a3 = a2 + kstep; const char* b3 = b2 + kstep;
            if (last && has_next) S.a_ready(nxt);
            if constexpr (SP2) {
            PG8_LDB(B0, 0, 0); PG8_LDB(B1, 0, 1); PG8_SCHED; PG8_LDA(At, 0, 0); PG8_STAGE(PG8_SA(1, 1), a1 + hstepA, voffA);
            PG8_WAIT_V(8); PG8_WAIT_L(0); PG8_BAR; PG8_MMA(0, 0, At, B0); PG8_MMA(0, 1, At, B1); PG8_BAR; PG8_SCHED;
            PG8_LDA(At, 0, 1); PG8_STAGE(PG8_SB(0, 0), b2, voffB); PG8_STAGE(PG8_SB(0, 1), b2 + hstepB, voffB); PG8_STAGE(PG8_SA(0, 0), a2, voffA);
            PG8_WAIT_V(8); PG8_WAIT_L(0); PG8_BAR; PG8_MMA(1, 0, At, B0); PG8_MMA(1, 1, At, B1); PG8_BAR; PG8_SCHED;
            PG8_LDB(B0, 1, 0); PG8_LDB(B1, 1, 1); PG8_SCHED; PG8_LDA(At, 1, 0); PG8_STAGE(PG8_SA(0, 1), a2 + hstepA, voffA);
            PG8_WAIT_V(8); PG8_WAIT_L(0); PG8_BAR; PG8_MMA(0, 0, At, B0); PG8_MMA(0, 1, At, B1); PG8_BAR; PG8_SCHED;
            PG8_LDA(At, 1, 1); PG8_STAGE(PG8_SB(1, 0), b3, voffB); PG8_STAGE(PG8_SB(1, 1), b3 + hstepB, voffB); PG8_STAGE(PG8_SA(1, 0), a3, voffA);
            PG8_WAIT_V(8); PG8_WAIT_L(0); PG8_BAR; PG8_MMA(1, 0, At, B0); PG8_MMA(1, 1, At, B1); PG8_BAR; PG8_SCHED;
            } else {
            PG8_LDB(B0, 0, 0); PG8_SCHED; PG8_LDA(At, 0, 0); PG8_STAGE(PG8_SA(1, 1), a1 + hstepA, voffA);
            PG8_WAIT_L(8); PG8_BAR; PG8_WAIT_L(0); PG8_MMA(0, 0, At, B0); PG8_BAR; PG8_SCHED;
            PG8_LDB(B1, 0, 1); PG8_STAGE(PG8_SB(0, 0), b2, voffB);
            PG8_BAR; PG8_WAIT_L(0); PG8_MMA(0, 1, At, B1); PG8_BAR;
            PG8_LDA(At, 0, 1); PG8_STAGE(PG8_SA(0, 0), a2, voffA);
            PG8_BAR; PG8_WAIT_L(0); PG8_MMA(1, 0, At, B0); PG8_BAR; PG8_SCHED;
            PG8_STAGE(PG8_SB(0, 1), b2 + hstepB, voffB);
            PG8_WAIT_V(6); PG8_BAR; PG8_MMA(1, 1, At, B1); PG8_BAR;
            PG8_LDB(B0, 1, 0); PG8_SCHED; PG8_LDA(At, 1, 0); PG8_STAGE(PG8_SA(0, 1), a2 + hstepA, voffA);
            PG8_WAIT_L(8); PG8_BAR; PG8_WAIT_L(0); PG8_MMA(0, 0, At, B0); PG8_BAR; PG8_SCHED;
            PG8_LDB(B1, 1, 1); PG8_STAGE(PG8_SB(1, 0), b3, voffB);
            PG8_BAR; PG8_WAIT_L(0); PG8_MMA(0, 1, At, B1); PG8_BAR;
            PG8_LDA(At, 1, 1); PG8_STAGE(PG8_SA(1, 0), a3, voffA);
            PG8_BAR; PG8_WAIT_L(0); PG8_MMA(1, 0, At, B0); PG8_BAR; PG8_SCHED;
            PG8_STAGE(PG8_SB(1, 1), b3 + hstepB, voffB);
            PG8_WAIT_V(6); PG8_BAR; PG8_MMA(1, 1, At, B1); PG8_BAR;
            }
        }
        if constexpr (ALIGN_EPI) { if (wr == 0) PG8_BAR; }
        if constexpr (!Epi::AFTER_DRAIN) { E(acc, cur, wr, wc, fr, fq); S.done(cur); }
        if (!has_next) break;
#pragma unroll
        for (int a = 0; a < 2; ++a)
#pragma unroll
            for (int b = 0; b < 2; ++b)
#pragma unroll
                for (int m = 0; m < 4; ++m)
#pragma unroll
                    for (int n = 0; n < 2; ++n) acc[a][b][m][n] = (f32x4){0.f, 0.f, 0.f, 0.f};
        cur = nxt; cA = nA; cB = nB; ++ui;
        if constexpr (ALIGN_EPI) { if (wr == 1) PG8_BAR; }
    }
    PG8_WAIT_V(0);
    if constexpr (!ALIGN_EPI) { if (wr == 0) PG8_BAR; }
    PG8_BAR;
    if constexpr (Epi::AFTER_DRAIN) { E.fused(acc, cur, wr, wc, fr, fq, lds, wid, lane); S.done(cur); }
#undef PG8_SA
#undef PG8_SB
#undef PG8_STAGE
#undef PG8_LDA
#undef PG8_LDB
#undef PG8_MMA
#undef PG8_WAIT_V
#undef PG8_WAIT_L
#undef PG8_BAR
#undef PG8_SCHED
}
}
namespace attn_body {
using bf16=__hip_bfloat16;
using bf16x8=__attribute__((ext_vector_type(8)))short;
using s16x4=__attribute__((ext_vector_type(4)))short;
using f32x16=__attribute__((ext_vector_type(16)))float;
using u32x4=__attribute__((ext_vector_type(4)))unsigned;
constexpr int D=64,DM=ZP;
constexpr int NW=8,QBLK=32,QB=QBLK*NW,KVBLK=64;
constexpr int ATTN_PITCH=DM, ATTN_UNIT_ROWS=QB;
__device__ __forceinline__ int crow(int r,int hi){return (r&3)+8*(r>>2)+4*hi;}
#define SBAR() __builtin_amdgcn_sched_barrier(0)
__device__ __forceinline__ void cmask(f32x16&p0,f32x16&p1,int jb,int qrel,int hi){
  const float NEG=-INFINITY; int kb=64*jb+4*hi;
  #pragma unroll
  for(int r=0;r<16;++r){int kv=kb+(r&3)+8*(r>>2); if(kv>qrel)p0[r]=NEG; if(kv+32>qrel)p1[r]=NEG;}
}

constexpr int NSLOT=3, SLOTB=8192;
constexpr int LDS_K=0, LDS_V=NSLOT*SLOTB, LDS_WS=2*NSLOT*SLOTB, LDS_OST=LDS_WS+NW*64*4, LDS_BYTES=LDS_OST+NW*4096;
constexpr float C2=0.125f*1.4426950408889634f;
__device__ __forceinline__ void glds16(const void*gsrc,unsigned lds_dst){unsigned keep;
  asm volatile("s_mov_b32 %0, m0\n\ts_mov_b32 m0, %2\n\ts_nop 0\n\tglobal_load_lds_dwordx4 %1, off\n\ts_mov_b32 m0, %0":"=&s"(keep):"v"(gsrc),"s"(lds_dst):"memory");}
__device__ __forceinline__ float max3f(float a,float b,float c){float r;asm("v_max3_f32 %0, %1, %2, %3":"=v"(r):"v"(a),"v"(b),"v"(c));return r;}
__device__ __forceinline__ float max2f(float a,float b){float r;asm("v_max_f32_e32 %0, %1, %2":"=v"(r):"v"(a),"v"(b));return r;}
__device__ __forceinline__ float fadd_s(float a,float b){float r;asm("v_add_f32_e32 %0, %1, %2":"=v"(r):"v"(a),"v"(b));return r;}
__device__ __forceinline__ float fsub_s(float a,float b){float r;asm("v_sub_f32_e32 %0, %1, %2":"=v"(r):"v"(a),"v"(b));return r;}
typedef float f32x2_t __attribute__((ext_vector_type(2))); typedef __bf16 bf16x2_t __attribute__((ext_vector_type(2)));
__device__ __forceinline__ unsigned cvtpk_s(float lo,float hi){f32x2_t v={lo,hi};bf16x2_t b=__builtin_convertvector(v,bf16x2_t);return __builtin_bit_cast(unsigned,b);}
#define WAIT_BAR(N) asm volatile("s_waitcnt vmcnt(" #N ") lgkmcnt(0)\n\ts_barrier":::"memory")

__device__ __forceinline__ void qkt(f32x16&p0,f32x16&p1,const char*Kslot,const bf16x8*qr,const f32x16&negm,int r32,int hi){
  const char*kb=Kslot+hi*1024+r32*16;
  #pragma unroll
  for(int d0=0;d0<4;++d0){
    const bf16x8 b0=*reinterpret_cast<const bf16x8*>(kb+d0*2048);
    const bf16x8 b1=*reinterpret_cast<const bf16x8*>(kb+d0*2048+512);
    if(d0==0){p0=__builtin_amdgcn_mfma_f32_32x32x16_bf16(b0,qr[0],negm,0,0,0);p1=__builtin_amdgcn_mfma_f32_32x32x16_bf16(b1,qr[0],negm,0,0,0);}
    else{p0=__builtin_amdgcn_mfma_f32_32x32x16_bf16(b0,qr[d0],p0,0,0,0);p1=__builtin_amdgcn_mfma_f32_32x32x16_bf16(b1,qr[d0],p1,0,0,0);}}
}
typedef __attribute__((address_space(3))) const char* lds_cptr;
typedef short v4i16_t __attribute__((ext_vector_type(4)));
__device__ __forceinline__ void kload8(bf16x8*kf,lds_cptr kp){
  kf[0]=*(const __attribute__((address_space(3))) bf16x8*)(kp);      kf[1]=*(const __attribute__((address_space(3))) bf16x8*)(kp+512);
  kf[2]=*(const __attribute__((address_space(3))) bf16x8*)(kp+2048); kf[3]=*(const __attribute__((address_space(3))) bf16x8*)(kp+2560);
  kf[4]=*(const __attribute__((address_space(3))) bf16x8*)(kp+4096); kf[5]=*(const __attribute__((address_space(3))) bf16x8*)(kp+4608);
  kf[6]=*(const __attribute__((address_space(3))) bf16x8*)(kp+6144); kf[7]=*(const __attribute__((address_space(3))) bf16x8*)(kp+6656);
}
__device__ __forceinline__ void kload2(bf16x8*kf,lds_cptr kp,int j){ kf[2*j]=*(const __attribute__((address_space(3))) bf16x8*)(kp+j*2048); kf[2*j+1]=*(const __attribute__((address_space(3))) bf16x8*)(kp+j*2048+512); }
__device__ __forceinline__ s16x4 vtr(lds_cptr p){ return __builtin_bit_cast(s16x4,__builtin_amdgcn_ds_read_tr16_b64_v4i16((__attribute__((address_space(3))) v4i16_t*)p)); }
__device__ __forceinline__ float rowmax(const f32x16&p0,const f32x16&p1){
  float a=max3f(p0[0],p0[1],p1[0]),b=max3f(p0[2],p0[3],p1[1]);a=max3f(a,p1[2],p1[3]);
  #pragma unroll
  for(int r=4;r<16;r+=4){a=max3f(a,p0[r],p0[r+1]);b=max3f(b,p0[r+2],p0[r+3]);a=max3f(a,p1[r],p1[r+1]);b=max3f(b,p1[r+2],p1[r+3]);}
  const float m=max2f(a,b);
  auto rr=__builtin_amdgcn_permlane32_swap(__float_as_uint(m),__float_as_uint(m),false,false);
  return max2f(__uint_as_float(rr[0]),__uint_as_float(rr[1]));
}
__device__ __forceinline__ void pv(f32x16*o,int vb,bf16x8 pa0,bf16x8 pa1,bf16x8 pa2,bf16x8 pa3){
  #pragma unroll
  for(int d0=0;d0<2;++d0){s16x4 lo[4],hi[4];
    #pragma unroll
    for(int ks=0;ks<4;++ks){
      asm volatile("ds_read_b64_tr_b16 %0,%1 offset:%c2":"=&v"(lo[ks]):"v"(vb),"i"(d0*4096+ks*1024):"memory");
      asm volatile("ds_read_b64_tr_b16 %0,%1 offset:%c2":"=&v"(hi[ks]):"v"(vb),"i"(d0*4096+ks*1024+512):"memory");}
    asm volatile("s_waitcnt lgkmcnt(0)":::"memory");SBAR();
    #define PK(k) (bf16x8){lo[k][0],lo[k][1],lo[k][2],lo[k][3],hi[k][0],hi[k][1],hi[k][2],hi[k][3]}
    o[d0]=__builtin_amdgcn_mfma_f32_32x32x16_bf16(pa0,PK(0),o[d0],0,0,0);
    o[d0]=__builtin_amdgcn_mfma_f32_32x32x16_bf16(pa1,PK(1),o[d0],0,0,0);
    o[d0]=__builtin_amdgcn_mfma_f32_32x32x16_bf16(pa2,PK(2),o[d0],0,0,0);
    o[d0]=__builtin_amdgcn_mfma_f32_32x32x16_bf16(pa3,PK(3),o[d0],0,0,0);
    #undef PK
  }
}

#ifndef ATTN_STORE16
#define ATTN_STORE16(p,v) (*(u32x4*)(p)=(v))
#endif
template<int THRL> __device__ __forceinline__ void attn_unit(const bf16*Qu,const bf16*K0,const bf16*K1,int nt0,int NT,char*shm){
  int tid_=threadIdx.x; asm volatile("":"+v"(tid_));
  const int tid=tid_,lane=tid&63,r32=lane&31,hi=lane>>5; const int wid=__builtin_amdgcn_readfirstlane(tid>>6);
  const bf16*Qw=Qu+(long)(wid*QBLK)*DM;
  const unsigned lds0=(unsigned)(uintptr_t)shm;
  float*wsf=(float*)(shm+LDS_WS)+wid*64;
  const bf16*ksrc0=K0+(long)lane*DM+wid*8,*ksrc1=K1+(long)lane*DM+wid*8;
  const long voff_=(long)(16*(wid&3)+(lane>>2))*DM+(wid>>2)*32+(lane&3)*8+(C_V-C_K); const bf16*vsrc0=K0+voff_,*vsrc1=K1+voff_;
  const unsigned kdst=lds0+LDS_K+wid*1024, vdst=lds0+LDS_V+wid*1024;
  #define DMA_K(t,slot) glds16(((t)<nt0?ksrc0+(long)(t)*KVBLK*DM:ksrc1+(long)((t)-nt0)*KVBLK*DM),(unsigned)__builtin_amdgcn_readfirstlane(kdst+(slot)))
  #define DMA_V(t,slot) glds16(((t)<nt0?vsrc0+(long)(t)*KVBLK*DM:vsrc1+(long)((t)-nt0)*KVBLK*DM),(unsigned)__builtin_amdgcn_readfirstlane(vdst+(slot)))
  const int vb0=(int)(lds0+LDS_V)+((lane>>4)&1)*32+(lane&3)*8+(4*hi+((lane&15)>>2))*64;
  const char*Kbase=shm+LDS_K; bf16x8 kf[8];
  const lds_cptr shm3=(lds_cptr)shm; const lds_cptr kp0=shm3+LDS_K+hi*1024+r32*16; const lds_cptr vp0=shm3+LDS_V+((lane>>4)&1)*32+(lane&3)*8+(4*hi+((lane&15)>>2))*64;
  DMA_K(0,0);DMA_V(0,0);DMA_K(1,SLOTB);
  bf16x8 qr[4];
  #pragma unroll
  for(int d0=0;d0<4;++d0)qr[d0]=*reinterpret_cast<const bf16x8*>(&Qw[(long)r32*DM+d0*16+hi*8]);
  float mhat=0.f,l_reg=0.f;f32x16 o[2];o[0]=f32x16{};o[1]=f32x16{};f32x16 negm=f32x16{};asm volatile("":"+v"(negm));
  #define CMASK(P0,P1,t) do{}while(0)
  bool resc=false;
  #define START(P0,P1) do{ const float rm=rowmax(P0,P1); resc=false; \
    { const float dl=rm; mhat=fadd_s(mhat,dl); \
      _Pragma("unroll") for(int r=0;r<16;++r){P0[r]=fsub_s(P0[r],dl);P1[r]=fsub_s(P1[r],dl);} \
      _Pragma("unroll") for(int r=0;r<16;++r)negm[r]=-mhat; asm volatile("":"+v"(negm)); } \
    _Pragma("unroll") for(int r=0;r<16;++r)P0[r]=__builtin_amdgcn_exp2f(P0[r]); }while(0)
  #define RESC() do{ if(resc){ asm volatile("s_waitcnt lgkmcnt(0)":::"memory"); \
      _Pragma("unroll") for(int d_=0;d_<2;++d_) _Pragma("unroll") for(int r=0;r<16;++r)o[d_][r]*=wsf[crow(r,hi)]; } }while(0)
  f32x16 pA0,pA1,pB0,pB1;
  int sl_prev=0,sl_cur=0,sl_next=SLOTB;
  #define ROT() do{sl_prev=sl_cur;sl_cur=sl_next;sl_next=(sl_next==(NSLOT-1)*SLOTB)?0:sl_next+SLOTB;}while(0)
  DMA_K(2,2*SLOTB);
  WAIT_BAR(3);
  qkt(pA0,pA1,Kbase,qr,negm,r32,hi);asm volatile("s_nop 15\n\ts_nop 7":"+v"(pA0),"+v"(pA1));CMASK(pA0,pA1,0);
  START(pA0,pA1);
  _Pragma("unroll") for(int r=0;r<16;++r)pA1[r]=__builtin_amdgcn_exp2f(pA1[r]);
  WAIT_BAR(0);
  DMA_K(3,0);DMA_V(1,SLOTB);
  ROT();
  kload8(kf,kp0+sl_cur);
  WAIT_BAR(2);
  s16x4 vlo[8],vhi[8]; u32x4 pw0,pw1,pw2,pw3;
  #define PKW(P,B) cvtpk_s(P[B],P[B+1])
  #define PAF(k) __builtin_bit_cast(bf16x8,pw##k)
  #define VFR(i) (bf16x8){vlo[i][0],vlo[i][1],vlo[i][2],vlo[i][3],vhi[i][0],vhi[i][1],vhi[i][2],vhi[i][3]}
  #define PIN(x) asm volatile("":"+v"(x))
  #define MX3(a,b,c) __builtin_fmaxf(__builtin_fmaxf((a),(b)),(c))
  #define GAPA(MF,A0,A1,A2,A3,W0,W1,PW) do{ MF; sacc+=A0; sacc+=A1; sacc+=A2; sacc+=A3; PIN(sacc); W0; W1; PIN(PW); SBAR(); }while(0)
  #define EX(v) __builtin_amdgcn_exp2f(v)
  #define GAPB(MF,X,B) do{ MF; X[B]=EX(X[B]); X[B+1]=EX(X[B+1]); X[B+2]=EX(X[B+2]); X[B+3]=EX(X[B+3]); PIN(X); SBAR(); }while(0)
  #define VRD(i) do{ vlo[i]=vtr(vp_+(((i)>>2)*4096+((i)&3)*1024)); vhi[i]=vtr(vp_+(((i)>>2)*4096+((i)&3)*1024+512)); }while(0)
  #define KRD(G,j) do{ if(G){ kload2(kf,kp0+sl_next,j); SBAR(); } }while(0)
  #define STEP(C0,C1,P0,P1,t,GK,GV,GL) do{ SBAR(); \
    const lds_cptr vp_=vp0+sl_prev; \
    VRD(0); SBAR(); float sacc=(P0[0]+P0[1]); \
    GAPA(C0=__builtin_amdgcn_mfma_f32_32x32x16_bf16(kf[0],qr[0],negm,0,0,0), P0[2],P0[3],P0[4],P0[5],     pw0[0]=PKW(P0,0), pw0[1]=PKW(P0,2), pw0); \
    VRD(4); SBAR(); GAPA(C1=__builtin_amdgcn_mfma_f32_32x32x16_bf16(kf[1],qr[0],negm,0,0,0), P0[6],P0[7],P0[8],P0[9],     pw0[2]=PKW(P0,4), pw0[3]=PKW(P0,6), pw0); \
    VRD(1); SBAR(); GAPA(C0=__builtin_amdgcn_mfma_f32_32x32x16_bf16(kf[2],qr[1],C0,0,0,0),   P0[10],P0[11],P0[12],P0[13], pw1[0]=PKW(P0,8), pw1[1]=PKW(P0,10), pw1); \
    VRD(5); SBAR(); GAPA(C1=__builtin_amdgcn_mfma_f32_32x32x16_bf16(kf[3],qr[1],C1,0,0,0),   P0[14],P0[15],P1[0],P1[1],   pw1[2]=PKW(P0,12),pw1[3]=PKW(P0,14), pw1); \
    VRD(2); SBAR(); GAPA(C0=__builtin_amdgcn_mfma_f32_32x32x16_bf16(kf[4],qr[2],C0,0,0,0),   P1[2],P1[3],P1[4],P1[5],     pw2[0]=PKW(P1,0), pw2[1]=PKW(P1,2), pw2); \
    VRD(6); SBAR(); GAPA(C1=__builtin_amdgcn_mfma_f32_32x32x16_bf16(kf[5],qr[2],C1,0,0,0),   P1[6],P1[7],P1[8],P1[9],     pw2[2]=PKW(P1,4), pw2[3]=PKW(P1,6), pw2); \
    VRD(3); SBAR(); GAPA(C0=__builtin_amdgcn_mfma_f32_32x32x16_bf16(kf[6],qr[3],C0,0,0,0),   P1[10],P1[11],P1[12],P1[13], pw3[0]=PKW(P1,8), pw3[1]=PKW(P1,10), pw3); \
    VRD(7); SBAR(); GAPA(C1=__builtin_amdgcn_mfma_f32_32x32x16_bf16(kf[7],qr[3],C1,0,0,0),   P1[14],P1[15],0.f,0.f,       pw3[2]=PKW(P1,12),pw3[3]=PKW(P1,14), pw3); \
    l_reg+=sacc; \
    if(GK){DMA_K((t)+3,sl_cur);} if(GV){DMA_V((t)+1,sl_next);} \
    CMASK(C0,C1,t); \
    { float a=MX3(C0[0],C0[1],C1[0]),b=MX3(C0[2],C0[3],C1[1]); a=MX3(a,C1[2],C1[3]); \
      _Pragma("unroll") for(int r=4;r<16;r+=4){a=MX3(a,C0[r],C0[r+1]);b=MX3(b,C0[r+2],C0[r+3]);a=MX3(a,C1[r],C1[r+1]);b=MX3(b,C1[r+2],C1[r+3]);} \
      float rm=__builtin_fmaxf(a,b); { auto rr=__builtin_amdgcn_permlane32_swap(__float_as_uint(rm),__float_as_uint(rm),false,false); rm=__builtin_fmaxf(__uint_as_float(rr[0]),__uint_as_float(rr[1])); } \
      resc=false; \
      if(__builtin_expect(__any(rm>(float)THRL),0)){ const float dl=__builtin_fmaxf(rm,0.f); mhat+=dl; \
        _Pragma("unroll") for(int r=0;r<16;++r){C0[r]-=dl;C1[r]-=dl;} \
        _Pragma("unroll") for(int r=0;r<16;++r)negm[r]=-mhat; asm volatile("":"+v"(negm)); \
        const float f=__builtin_amdgcn_exp2f(-dl); l_reg*=f; if(hi==0)wsf[r32]=f; resc=true; } } \
    SBAR(); \
    GAPB(o[0]=__builtin_amdgcn_mfma_f32_32x32x16_bf16(PAF(0),VFR(0),o[0],0,0,0), C0,0); \
    GAPB(o[1]=__builtin_amdgcn_mfma_f32_32x32x16_bf16(PAF(0),VFR(4),o[1],0,0,0), C0,4); \
    KRD(GL,0); GAPB(o[0]=__builtin_amdgcn_mfma_f32_32x32x16_bf16(PAF(1),VFR(1),o[0],0,0,0), C0,8); \
    KRD(GL,1); GAPB(o[1]=__builtin_amdgcn_mfma_f32_32x32x16_bf16(PAF(1),VFR(5),o[1],0,0,0), C0,12); \
    KRD(GL,2); GAPB(o[0]=__builtin_amdgcn_mfma_f32_32x32x16_bf16(PAF(2),VFR(2),o[0],0,0,0), C1,0); \
    KRD(GL,3); GAPB(o[1]=__builtin_amdgcn_mfma_f32_32x32x16_bf16(PAF(2),VFR(6),o[1],0,0,0), C1,4); \
    GAPB(o[0]=__builtin_amdgcn_mfma_f32_32x32x16_bf16(PAF(3),VFR(3),o[0],0,0,0), C1,8); \
    GAPB(o[1]=__builtin_amdgcn_mfma_f32_32x32x16_bf16(PAF(3),VFR(7),o[1],0,0,0), C1,12); \
    }while(0)
  int t=1;
  #undef CMASK
  #define CMASK(P0,P1,t) do{}while(0)
  for(;t+5<NT;t+=2){
    STEP(pB0,pB1,pA0,pA1,t,true,true,true);     WAIT_BAR(2); RESC(); ROT();
    STEP(pA0,pA1,pB0,pB1,t+1,true,true,true);   WAIT_BAR(2); RESC(); ROT();
  }
  #undef CMASK
  #define CMASK(P0,P1,t) do{}while(0)
  #define ENDW(tt) do{ if((tt)+3<NT){WAIT_BAR(2);} else if((tt)+2<NT){WAIT_BAR(1);} else {WAIT_BAR(0);} }while(0)
  for(;t+1<NT;t+=2){
    STEP(pB0,pB1,pA0,pA1,t,(t+3<NT),(t+1<NT),(t+1<NT));       ENDW(t);   RESC(); ROT();
    STEP(pA0,pA1,pB0,pB1,t+1,(t+4<NT),(t+2<NT),(t+2<NT));     ENDW(t+1); RESC(); ROT();
  }
  STEP(pB0,pB1,pA0,pA1,NT-1,false,false,false); RESC();
  { float sacc=pB0[0]+pB0[1]; _Pragma("unroll") for(int r=2;r<16;++r)sacc+=pB0[r]; _Pragma("unroll") for(int r=0;r<16;++r)sacc+=pB1[r]; l_reg+=sacc;
    pw0=(u32x4){PKW(pB0,0),PKW(pB0,2),PKW(pB0,4),PKW(pB0,6)};pw1=(u32x4){PKW(pB0,8),PKW(pB0,10),PKW(pB0,12),PKW(pB0,14)};pw2=(u32x4){PKW(pB1,0),PKW(pB1,2),PKW(pB1,4),PKW(pB1,6)};pw3=(u32x4){PKW(pB1,8),PKW(pB1,10),PKW(pB1,12),PKW(pB1,14)};
    SBAR(); pv(o,vb0+sl_cur,PAF(0),PAF(1),PAF(2),PAF(3)); }
  #undef PKW
  #undef PAF
  #undef VFR
  #undef PIN
  #undef MX3
  #undef GAPA
  #undef GAPB
  #undef EX
  #undef VRD
  #undef KRD
  #undef STEP
  #undef ENDW
  {auto rr=__builtin_amdgcn_permlane32_swap(__float_as_uint(l_reg),__float_as_uint(l_reg),false,false);l_reg=__uint_as_float(rr[0])+__uint_as_float(rr[1]);}
  if(hi==0)wsf[32+r32]=l_reg;asm volatile("s_waitcnt lgkmcnt(0)":::"memory");
  float rli[16];
  #pragma unroll
  for(int r=0;r<16;++r)rli[r]=__builtin_amdgcn_rcpf(wsf[32+crow(r,hi)]);
  bf16*Ow=(bf16*)Qw; const bf16*Gw=Qw+(C_GB-C_Q);
  { bf16*stg=(bf16*)(shm+LDS_OST)+wid*2048;
    #pragma unroll
    for(int r=0;r<16;++r){const int orow=crow(r,hi);
      #pragma unroll
      for(int d0=0;d0<2;++d0)stg[orow*64+d0*32+r32]=__float2bfloat16(o[d0][r]*rli[r]);}
    asm volatile("s_waitcnt lgkmcnt(0)":::"memory");
    #pragma unroll
    for(int i=0;i<4;++i){const int row=i*8+(lane>>3),ch=lane&7; const u32x4 v=*(const u32x4*)(stg+row*64+ch*8); const u32x4 gt=*(const u32x4*)(Gw+(long)row*DM+ch*8); u32x4 w;
      #pragma unroll
      for(int q_=0;q_<4;++q_){ const float a0=__uint_as_float(v[q_]<<16)*__uint_as_float(gt[q_]<<16), a1=__uint_as_float(v[q_]&0xffff0000u)*__uint_as_float(gt[q_]&0xffff0000u); w[q_]=cvtpk_s(a0,a1); }
      ATTN_STORE16(Ow+(long)row*DM+ch*8,w);} }
  asm volatile("s_waitcnt lgkmcnt(0)\n\ts_barrier":::"memory");
  #undef DMA_K
  #undef DMA_V
  #undef CMASK
  #undef START
  #undef RESC
  #undef ROT
}
constexpr int ATTN_LDS_BYTES=LDS_BYTES;
#undef SBAR
#undef WAIT_BAR
}

constexpr int NWAVES = 8;
#ifndef MK_PER_PHASE
#define MK_PER_PHASE 0
#endif
constexpr size_t MiB = 1u << 20;
constexpr size_t WS_CTL = 0, CTL_ZERO_BYTES = 1 * MiB;
constexpr size_t WS_MODS = 1 * MiB, WS_ROPE = 2 * MiB, WS_AWS = 2 * MiB + 512 * 1024, WS_LRUW = 3 * MiB, WS_WIN = 4 * MiB, WS_WO = 24 * MiB, WS_XR = 34 * MiB,
                 WS_XM = 52 * MiB, WS_XT = 124 * MiB, WS_Z = 268 * MiB, WS_END = 484 * MiB;
static_assert(WS_WIN + (size_t)DEPTH * DIN * DMODEL * 2 <= WS_WO && WS_WO + (size_t)DEPTH * DMODEL * K2 * 2 <= WS_XR && WS_XR + (size_t)MROWS * 256 * 2 <= WS_XM &&
              WS_XM + (size_t)MROWS * DMODEL * 2 <= WS_XT && WS_XT + (size_t)MROWS * DMODEL * 4 <= WS_Z && WS_Z + (size_t)MROWS * ZP * 2 <= WS_END, "d_ws map");
constexpr int CW_BAR = 4096, CW_Q = 16384;
constexpr int RING_OFF = 0, RING_BYTES = 131072, LDSCTL_OFF = RING_BYTES, MISC_OFF = LDSCTL_OFF + 320, LDS_BYTES = 147456;
constexpr int NPHASE = 2 + 4 * DEPTH;

#define GAS __attribute__((address_space(1)))
#define LAS __attribute__((address_space(3)))
typedef unsigned short bf16;
typedef unsigned v4u __attribute__((ext_vector_type(4)));
typedef unsigned v2u __attribute__((ext_vector_type(2)));
typedef float f32x4 __attribute__((ext_vector_type(4)));
typedef float f32x16 __attribute__((ext_vector_type(16)));
typedef short bf16x8 __attribute__((ext_vector_type(8)));
typedef GAS unsigned gu32;
#define RLX_AGENT __ATOMIC_RELAXED, __HIP_MEMORY_SCOPE_AGENT
#define LDS_WAIT() asm volatile("s_waitcnt lgkmcnt(0)" ::: "memory")
#define VM_WAIT() asm volatile("s_waitcnt vmcnt(0)" ::: "memory")
__device__ __forceinline__ unsigned f2bf(float f) { unsigned u = __builtin_bit_cast(unsigned, f); return (u + 0x7fffu + ((u >> 16) & 1u)) >> 16; }
__device__ __forceinline__ unsigned pk2(float lo, float hi) { return f2bf(lo) | (f2bf(hi) << 16); }
__device__ __forceinline__ float bflo(unsigned w) { return __uint_as_float(w << 16); }
__device__ __forceinline__ float bfhi(unsigned w) { return __uint_as_float(w & 0xffff0000u); }
__device__ __forceinline__ float bf1(bf16 h) { return __uint_as_float((unsigned)h << 16); }
__device__ __forceinline__ int crow16(int r, int hi) { return (r & 3) + 8 * (r >> 2) + 4 * hi; }

#define XB_TMO      128
#define XB_XCNT(j)  (256  + 64 * (j))
#define XB_XSUB(j)  (1280 + 64 * (j))
#define XB_XGEN(j)  (2304 + 64 * (j))
#define XB_TOP      3328
#define XB_TOPGEN   3392
#define XCD_BAR_WORDS 3456
#define XB_SPIN_CAP (1u << 20)
__device__ __forceinline__ unsigned xb_ld(unsigned* p)              { return __hip_atomic_load(p, __ATOMIC_RELAXED, __HIP_MEMORY_SCOPE_AGENT); }
__device__ __forceinline__ unsigned xb_add(unsigned* p, unsigned v) { return __hip_atomic_fetch_add(p, v, __ATOMIC_RELAXED, __HIP_MEMORY_SCOPE_AGENT); }
__device__ __forceinline__ unsigned xb_xcc_id() { return (unsigned)__builtin_amdgcn_s_getreg((3 << 11) | 20) & 0xFu; }
#define XB_SPIN(cond, bar) do { unsigned _sp = 0; while (cond) { __builtin_amdgcn_s_sleep(1); \
    if ((++_sp & 255u) == 0u) { if (xb_ld(&(bar)[XB_TMO])) break; if (_sp > XB_SPIN_CAP) { atomicAdd(&(bar)[XB_TMO], 1u); break; } } } } while (0)
struct XcdBarrier { unsigned* bar; unsigned x; volatile LAS unsigned* st; };
__device__ __forceinline__ XcdBarrier xcd_barrier_post(unsigned* bar, volatile LAS unsigned* st) {
    XcdBarrier b; b.bar = bar; b.x = xb_xcc_id(); b.st = st;
    if (threadIdx.x == 0) (void)xb_add(&bar[XB_XCNT(b.x)], 1u);
    return b;
}
__device__ __forceinline__ void xcd_barrier_complete(unsigned* bar, unsigned x, unsigned& nloc, unsigned& nx) {
    const unsigned G = gridDim.x * gridDim.y * gridDim.z;
    unsigned sum, cnt, mine, sp = 0u;
    for (;;) {
        sum = 0u; cnt = 0u; mine = 0u;
#pragma unroll
        for (unsigned j = 0; j < 16; ++j) { const unsigned c = xb_ld(&bar[XB_XCNT(j)]); sum += c; cnt += (c > 0u) ? 1u : 0u; mine = (j == x) ? c : mine; }
        if (sum == G) break;
        __builtin_amdgcn_s_sleep(1);
        if ((++sp & 255u) == 0u) { if (xb_ld(&bar[XB_TMO])) break; if (sp > XB_SPIN_CAP) { atomicAdd(&bar[XB_TMO], 1u); break; } }
    }
    nloc = mine > 0u ? mine : 1u; nx = cnt > 0u ? cnt : 1u;
}
__device__ __forceinline__ void xcd_barrier(const XcdBarrier& b) {
    asm volatile("s_waitcnt vmcnt(0)" ::: "memory");
    __syncthreads();
    if (threadIdx.x == 0) {
        unsigned* bar = b.bar;
        __builtin_amdgcn_s_waitcnt(0);
        unsigned nloc = b.st[0], nx = b.st[1];
        if (nloc == 0u) { xcd_barrier_complete(bar, b.x, nloc, nx); b.st[0] = nloc; b.st[1] = nx; }
        const unsigned old = xb_add(&bar[XB_XSUB(b.x)], 1u);
        const unsigned gen = old / nloc;
        if (old + 1u == (gen + 1u) * nloc) {
            __builtin_amdgcn_fence(__ATOMIC_RELEASE, "agent");
            asm volatile("s_waitcnt vmcnt(0)" ::: "memory");
            const unsigned og = xb_add(&bar[XB_TOP], 1u);
            const unsigned tg = og / nx;
            if (og + 1u == (tg + 1u) * nx) xb_add(&bar[XB_TOPGEN], 1u);
            else XB_SPIN(xb_ld(&bar[XB_TOPGEN]) == tg, bar);
            __builtin_amdgcn_fence(__ATOMIC_ACQUIRE, "agent");
            xb_add(&bar[XB_XGEN(b.x)], 1u);
            asm volatile("s_waitcnt vmcnt(0)" ::: "memory");
        } else {
            XB_SPIN(xb_ld(&bar[XB_XGEN(b.x)]) == gen, bar);
            __builtin_amdgcn_fence(__ATOMIC_ACQUIRE, "agent");
            asm volatile("s_waitcnt vmcnt(0)" ::: "memory");
        }
    }
    __syncthreads();
}

__device__ __forceinline__ const float* inptr(int i) { const float* const* ka = (const float* const*)__builtin_amdgcn_kernarg_segment_ptr(); asm volatile("" : "+s"(i)); return ka[i]; }
struct Frame {
    LAS unsigned char* lds; unsigned char* ldsg;
    volatile LAS unsigned* MISC;
    gu32* ctl;
    int tid, lane, wave, bid, G;
    unsigned char* ws;
};

__device__ __forceinline__ float wave_sum(float v) {
#pragma unroll
    for (int o = 1; o < 64; o <<= 1) v += __shfl_xor(v, o);
    return v;
}

__device__ __forceinline__ void p0_transpose_item(const float* W, int ldsrc, int k0s, int c0s, bf16* WT, int ldd, int n0, int k0d, bool permq, LAS float* scr, int lane) {
    const int j = lane & 31; const int pos = permq ? (8 * ((j >> 2) & 3) + 4 * (j >> 4) + (j & 3)) : j;
#pragma unroll 8
    for (int i = 0; i < 32; ++i) { const int kk = 2 * i + (lane >> 5); scr[kk * 33 + pos] = W[(size_t)(k0s + kk) * ldsrc + c0s + j]; }
    LDS_WAIT(); asm volatile("" ::: "memory");
    const int c = lane & 7;
#pragma unroll
    for (int jj = 0; jj < 4; ++jj) { const int n = (lane >> 3) + 8 * jj; const LAS float* s = scr + (8 * c) * 33 + n;
        v4u o; o.x = pk2(s[0 * 33], s[1 * 33]); o.y = pk2(s[2 * 33], s[3 * 33]); o.z = pk2(s[4 * 33], s[5 * 33]); o.w = pk2(s[6 * 33], s[7 * 33]);
        *(GAS v4u*)(WT + (size_t)(n0 + n) * ldd + k0d + 8 * c) = o; }
    LDS_WAIT(); asm volatile("" ::: "memory");
}
__device__ __forceinline__ void p0a(Frame& F) {
    bf16* const AWS_ = (bf16*)(F.ws + WS_AWS); bf16* const LRUW_ = (bf16*)(F.ws + WS_LRUW); bf16* const WIN_ = (bf16*)(F.ws + WS_WIN); bf16* const WO_ = (bf16*)(F.ws + WS_WO); const float* const a_ws_ = inptr(9); const float* const b_ada_ = inptr(5); const float* const c_ = inptr(1); const float* const cctx_ = inptr(3); const float* const lru_wi_ = inptr(17); const float* const lru_wr_ = inptr(15); float* const mods_ = (float*)(F.ws + WS_MODS); float* const rope_ = (float*)(F.ws + WS_ROPE); const float* const w_ada_ = inptr(4); const float* const w_in_ = inptr(6); const float* const w_o_ = inptr(20);
    int tid_ = threadIdx.x; asm volatile("" : "+v"(tid_)); const int tid = tid_, lane = tid & 63, wave = __builtin_amdgcn_readfirstlane(tid >> 6); (void)tid; (void)lane; (void)wave;
    {
        LAS float* sS = (LAS float*)F.lds; LAS float* red = (LAS float*)(F.lds + 17 * 1024 * 4);
        bool filled = false;
        for (int it = F.bid; it < DEPTH * 48; it += F.G) {
            const int l = it / 48, cb = it % 48;
            if (!filled) { for (int idx = tid; idx < 17 * 1024; idx += 512) { const int r = idx >> 10, k = idx & 1023; const float cv = r < 16 ? c_[r * 1024 + k] : cctx_[k]; sS[idx] = cv / (1.f + expf(-cv)); } filled = true; }
            __syncthreads();
            float acc[17];
#pragma unroll
            for (int r = 0; r < 17; ++r) acc[r] = 0.f;
            const float* wp = w_ada_ + ((size_t)l * 1024 + 128 * wave) * 3072 + 64 * cb + lane;
#pragma unroll 4
            for (int k = 0; k < 128; ++k) { const float wv = wp[(size_t)k * 3072];
#pragma unroll
                for (int r = 0; r < 17; ++r) acc[r] += sS[r * 1024 + 128 * wave + k] * wv; }
#pragma unroll
            for (int r = 0; r < 17; ++r) red[(wave * 17 + r) * 64 + lane] = acc[r];
            __syncthreads();
            for (int idx = tid; idx < 17 * 64; idx += 512) { const int r = idx >> 6, ln = idx & 63; float s = b_ada_[l * 3072 + 64 * cb + ln];
#pragma unroll
                for (int w = 0; w < 8; ++w) s += red[(w * 17 + r) * 64 + ln];
                mods_[((size_t)l * 17 + r) * 3072 + 64 * cb + ln] = s; }
            __syncthreads();
        }
    }
    if (F.bid == F.G - 1) {
        for (int idx = tid; idx < 1024; idx += 512) { const int pos = idx >> 4, i = idx & 15;
            const float inv = exp2f(-(float)i * (13.287712379549449f / 16.f)); const float ang = (float)pos * inv;
            const float kq = rintf(ang * 0.15915494309189535f); float rr = fmaf(-kq, 6.2831854820251465f, ang); rr = fmaf(-kq, -1.7484556e-7f, rr);
            rope_[idx] = __cosf(rr); rope_[1024 + idx] = __sinf(rr); }
    }
    __syncthreads();
    {
        LAS float* scr = (LAS float*)(F.lds + wave * 16384);
        const int gw = F.bid * NWAVES + wave, NGW = F.G * NWAVES;
        constexpr int I_IN = 16 * 80, I_O = 20 * 32;
        for (int it = gw; it < DEPTH * (I_IN + I_O); it += NGW) {
            const int l = it / (I_IN + I_O); int r = it % (I_IN + I_O);
            if (r < I_IN) {
                const int kb = r / 80, grp = r % 80;
                const int pn = grp >> 3, bj = (grp >> 2) & 1, wc = grp & 3;
                int lbase; bool pq = false;
                if (pn == 3 || pn == 4) { lbase = 768 + 64 * (wc + 4 * (pn - 3)) + 32 * bj; pq = true; }
                else if (pn == 5) { if (wc < 2) { lbase = 1280 + 64 * wc + 32 * bj; pq = true; } else lbase = 1408 + 64 * (wc - 2) + 32 * bj; }
                else { const int lb[10] = {0, 256, 512, 0, 0, 0, 1536, 1792, 2048, 2304}; lbase = lb[pn] + 128 * bj + 32 * wc; }
                p0_transpose_item(w_in_ + (size_t)l * DMODEL * DIN, DIN, 64 * kb, lbase, WIN_ + (size_t)l * DIN * DMODEL, DMODEL, 32 * grp, 64 * kb, pq, scr, lane);
            } else {
                r -= I_IN; const int kb = r / 32, nb = r % 32; const int k0d = 64 * kb, k0s = k0d < 1024 ? k0d : k0d - 256;
                p0_transpose_item(w_o_ + (size_t)l * DMODEL * DMODEL, DMODEL, k0s, 32 * nb, WO_ + (size_t)l * DMODEL * K2, K2, 32 * nb, k0d, false, scr, lane);
            }
        }
    }
    {
        const int gt = F.bid * 512 + tid, NT_ = F.G * 512;
        for (int i = gt; i < DEPTH * 4 * 128 * 128 / 4; i += NT_) { const f32x4 v = *(const f32x4*)(a_ws_ + (size_t)i * 4); v2u o; o.x = pk2(v[0], v[1]); o.y = pk2(v[2], v[3]); *(v2u*)(AWS_ + (size_t)i * 4) = o; }
        for (int i = gt; i < DEPTH * 2 * 4 * 2 * 2 * 4 * 64; i += NT_) {
            const int ln = i & 63, s = (i >> 6) & 3, nt = (i >> 8) & 1, g = (i >> 9) & 1, j = (i >> 10) & 3, d = (i >> 12) & 1, l = i >> 13;
            const float* w = (g == 0 ? lru_wr_ : lru_wi_) + ((size_t)((l * 2 + d) * 4 + j) * 64) * 64;
            const int col = 32 * nt + (ln & 31), i0 = 16 * s + 8 * (ln >> 5);
            v4u o; o.x = pk2(w[(i0 + 0) * 64 + col], w[(i0 + 1) * 64 + col]); o.y = pk2(w[(i0 + 2) * 64 + col], w[(i0 + 3) * 64 + col]);
            o.z = pk2(w[(i0 + 4) * 64 + col], w[(i0 + 5) * 64 + col]); o.w = pk2(w[(i0 + 6) * 64 + col], w[(i0 + 7) * 64 + col]);
            *(v4u*)(LRUW_ + (size_t)i * 8) = o; }
    }
}
__device__ __forceinline__ void p0b(Frame& F) {
    bf16* const XM_ = (bf16*)(F.ws + WS_XM); const float* const ctx_ = inptr(2); float* const mods_ = (float*)(F.ws + WS_MODS); const float* const x_ = inptr(0);
    int tid_ = threadIdx.x; asm volatile("" : "+v"(tid_)); const int tid = tid_, lane = tid & 63, wave = __builtin_amdgcn_readfirstlane(tid >> 6); (void)tid; (void)lane; (void)wave;
    const int gw = F.bid * NWAVES + wave, NGW = F.G * NWAVES;
    for (int m = gw; m < MROWS; m += NGW) {
        const float* src = m < NLAT ? x_ + (size_t)m * DMODEL : ctx_ + (size_t)(m - NLAT) * DMODEL; const int mrow = m < NLAT ? (m >> 11) : 16;
        const float* md = mods_ + (size_t)mrow * 3072;
        GAS v2u* o8 = (GAS v2u*)(XM_ + (size_t)m * DMODEL) + lane;
#pragma unroll
        for (int j = 0; j < 4; ++j) { const int k = 4 * lane + 256 * j; const f32x4 v = *(const f32x4*)(src + k), sh = *(const f32x4*)(md + k), sc = *(const f32x4*)(md + 1024 + k);
            const f32x4 o = v * (sc + 1.0f) + sh; v2u w; w.x = pk2(o[0], o[1]); w.y = pk2(o[2], o[3]); o8[64 * j] = w; }
    }
}
__device__ __forceinline__ void p4_ln(Frame& F, int l) {
    bf16* const XM_ = (bf16*)(F.ws + WS_XM); float* const XT_ = (float*)(F.ws + WS_XT); const float* const ln_b_ = inptr(22); const float* const ln_g_ = inptr(21); float* const mods_ = (float*)(F.ws + WS_MODS); float* const out_ = (float*)inptr(23);
    int tid_ = threadIdx.x; asm volatile("" : "+v"(tid_)); const int tid = tid_, lane = tid & 63, wave = __builtin_amdgcn_readfirstlane(tid >> 6); (void)tid; (void)lane; (void)wave;
    const int gw = F.bid * NWAVES + wave, NGW = F.G * NWAVES; const bool last = (l == DEPTH - 1); const int mend = last ? NLAT : MROWS;
    const float* lg = ln_g_ + l * DMODEL; const float* lb = ln_b_ + l * DMODEL;
    for (int m = gw; m < mend; m += NGW) {
        float* row = XT_ + (size_t)m * DMODEL; f32x4 v[4]; float s = 0.f;
#pragma unroll
        for (int j = 0; j < 4; ++j) { v[j] = *(const f32x4*)(row + 4 * lane + 256 * j); s += (v[j][0] + v[j][1]) + (v[j][2] + v[j][3]); }
        const float mean = wave_sum(s) * (1.f / DMODEL); float s2 = 0.f;
#pragma unroll
        for (int j = 0; j < 4; ++j) { v[j] = v[j] - mean; s2 += (v[j][0] * v[j][0] + v[j][1] * v[j][1]) + (v[j][2] * v[j][2] + v[j][3] * v[j][3]); }
        const float rstd = 1.f / sqrtf(wave_sum(s2) * (1.f / DMODEL) + 1e-6f);
        const int mrow = m < NLAT ? (m >> 11) : 16; const float* md = mods_ + ((size_t)(l + 1) * 17 + mrow) * 3072;
        GAS v2u* o8 = (GAS v2u*)(XM_ + (size_t)m * DMODEL) + lane;
#pragma unroll
        for (int j = 0; j < 4; ++j) { const int k = 4 * lane + 256 * j; const f32x4 o = v[j] * rstd * *(const f32x4*)(lg + k) + *(const f32x4*)(lb + k);
            if (last) { *(f32x4*)(out_ + (size_t)m * DMODEL + k) = o; }
            else { *(f32x4*)(row + k) = o; const f32x4 sh = *(const f32x4*)(md + k), sc = *(const f32x4*)(md + 1024 + k); const f32x4 xm = o * (sc + 1.0f) + sh;
                v2u w; w.x = pk2(xm[0], xm[1]); w.y = pk2(xm[2], xm[3]); o8[64 * j] = w; } }
    }
}
__device__ __forceinline__ void gmlp_unit(Frame& F, int l, int chunk) {
    bf16* const AWS_ = (bf16*)(F.ws + WS_AWS); bf16* const Z_ = (bf16*)(F.ws + WS_Z); const float* const a_bs_ = inptr(10); const float* const a_norm_b_ = inptr(8); const float* const a_norm_g_ = inptr(7);
    int tid_ = threadIdx.x; asm volatile("" : "+v"(tid_)); const int tid = tid_, lane = tid & 63, wave = __builtin_amdgcn_readfirstlane(tid >> 6); (void)tid; (void)lane; (void)wave; const int R0 = chunk * 128;
    constexpr int VP = 136;
    LAS bf16* VnT = (LAS bf16*)F.lds;
    {
        const int l5 = lane & 31, half = lane >> 5; const float* ng = a_norm_g_ + l * 256 + 8 * l5; const float* nb = a_norm_b_ + l * 256 + 8 * l5;
        const f32x4 g0 = *(const f32x4*)ng, g1 = *(const f32x4*)(ng + 4), b0 = *(const f32x4*)nb, b1 = *(const f32x4*)(nb + 4);
#pragma unroll 2
        for (int i = 0; i < 8; ++i) { const int tok = 16 * wave + 2 * i + half;
            const v4u raw = *(const v4u*)(Z_ + (size_t)(R0 + tok) * ZP + C_VA + 8 * l5);
            float v[8]; v[0] = bflo(raw.x); v[1] = bfhi(raw.x); v[2] = bflo(raw.y); v[3] = bfhi(raw.y); v[4] = bflo(raw.z); v[5] = bfhi(raw.z); v[6] = bflo(raw.w); v[7] = bfhi(raw.w);
            float s = ((v[0] + v[1]) + (v[2] + v[3])) + ((v[4] + v[5]) + (v[6] + v[7]));
#pragma unroll
            for (int o = 1; o < 32; o <<= 1) s += __shfl_xor(s, o);
            const float mu = s * (1.f / 256.f); float q = 0.f;
#pragma unroll
            for (int c = 0; c < 8; ++c) { v[c] -= mu; q += v[c] * v[c]; }
#pragma unroll
            for (int o = 1; o < 32; o <<= 1) q += __shfl_xor(q, o);
            const float rstd = 1.f / sqrtf(q * (1.f / 256.f) + 1e-6f);
#pragma unroll
            for (int c = 0; c < 8; ++c) { const float gg = c < 4 ? g0[c & 3] : g1[c & 3], bb = c < 4 ? b0[c & 3] : b1[c & 3]; VnT[(8 * l5 + c) * VP + tok] = (bf16)f2bf(v[c] * rstd * gg + bb); }
        }
    }
    __syncthreads();
    const int g = wave >> 1, ph = wave & 1, r32 = lane & 31, hi = lane >> 5;
    f32x16 acc[2][2];
#pragma unroll
    for (int a = 0; a < 2; ++a)
#pragma unroll
        for (int b = 0; b < 2; ++b)
#pragma unroll
            for (int e = 0; e < 16; ++e) acc[a][b][e] = 0.f;
    {
        const bf16* A0 = AWS_ + ((size_t)(l * 4 + g) * 128 + 64 * ph + r32) * 128 + 8 * hi;
        const LAS bf16* B0 = VnT + (64 * g + r32) * VP + 8 * hi;
#pragma unroll
        for (int s = 0; s < 8; ++s) {
            bf16x8 a[2], b[2];
#pragma unroll
            for (int mt = 0; mt < 2; ++mt) a[mt] = *(const bf16x8*)(A0 + mt * 32 * 128 + 16 * s);
#pragma unroll
            for (int nt = 0; nt < 2; ++nt) b[nt] = *(const LAS bf16x8*)(B0 + nt * 32 * VP + 16 * s);
#pragma unroll
            for (int mt = 0; mt < 2; ++mt)
#pragma unroll
                for (int nt = 0; nt < 2; ++nt) acc[mt][nt] = __builtin_amdgcn_mfma_f32_32x32x16_bf16(a[mt], b[nt], acc[mt][nt], 0, 0, 0);
        }
    }
    const float* bs = a_bs_ + (l * 4 + g) * 128;
#pragma unroll
    for (int mt = 0; mt < 2; ++mt)
#pragma unroll
        for (int reg = 0; reg < 16; ++reg) { const int p = 64 * ph + 32 * mt + crow16(reg, hi); const float bsv = bs[p]; bf16* zp = Z_ + (size_t)(R0 + p) * ZP + 64 * g + r32;
#pragma unroll
            for (int nt = 0; nt < 2; ++nt) { const float u = bf1(zp[C_MA + 32 * nt]), ga = bf1(zp[C_GA + 32 * nt]); zp[C_MA + 32 * nt] = (bf16)f2bf(u * (acc[mt][nt][reg] + bsv) * ga); } }
}
__device__ __forceinline__ void lru_conv_out(const v4u& r0, const v4u& r1, const v4u& r2, const v4u& r3, const f32x4 (&w0)[4], const f32x4 (&w1)[4], const f32x4& cb0, const f32x4& cb1, bf16* dst) {
    f32x4 y0 = cb0, y1 = cb1;
    y0 += w0[0] * (f32x4){bflo(r0.x), bfhi(r0.x), bflo(r0.y), bfhi(r0.y)}; y1 += w1[0] * (f32x4){bflo(r0.z), bfhi(r0.z), bflo(r0.w), bfhi(r0.w)};
    y0 += w0[1] * (f32x4){bflo(r1.x), bfhi(r1.x), bflo(r1.y), bfhi(r1.y)}; y1 += w1[1] * (f32x4){bflo(r1.z), bfhi(r1.z), bflo(r1.w), bfhi(r1.w)};
    y0 += w0[2] * (f32x4){bflo(r2.x), bfhi(r2.x), bflo(r2.y), bfhi(r2.y)}; y1 += w1[2] * (f32x4){bflo(r2.z), bfhi(r2.z), bflo(r2.w), bfhi(r2.w)};
    y0 += w0[3] * (f32x4){bflo(r3.x), bfhi(r3.x), bflo(r3.y), bfhi(r3.y)}; y1 += w1[3] * (f32x4){bflo(r3.z), bfhi(r3.z), bflo(r3.w), bfhi(r3.w)};
    v4u o; o.x = pk2(y0[0], y0[1]); o.y = pk2(y0[2], y0[3]); o.z = pk2(y1[0], y1[1]); o.w = pk2(y1[2], y1[3]);
    *(v4u*)dst = o;
}
__device__ __forceinline__ void lru_unit(Frame& F, int l, int b, int j) {
    int tid_ = threadIdx.x; asm volatile("" : "+v"(tid_)); const int tid = tid_, lane = tid & 63, wave = __builtin_amdgcn_readfirstlane(tid >> 6);
    bf16* const Z_ = (bf16*)(F.ws + WS_Z); bf16* const XR_ = (bf16*)(F.ws + WS_XR);
    {
        const float* const conv_w_ = inptr(13); const float* const conv_b_ = inptr(14);
        const int c8 = tid & 7, tg = tid >> 3; const int ch = 64 * j + 8 * c8;
        f32x4 w0[4], w1[4];
#pragma unroll
        for (int tap = 0; tap < 4; ++tap) { w0[tap] = *(const f32x4*)(conv_w_ + (l * 4 + tap) * 256 + ch); w1[tap] = *(const f32x4*)(conv_w_ + (l * 4 + tap) * 256 + ch + 4); }
        const f32x4 cb0 = *(const f32x4*)(conv_b_ + l * 256 + ch), cb1 = *(const f32x4*)(conv_b_ + l * 256 + ch + 4);
        const v4u zero = {0u, 0u, 0u, 0u};
#pragma unroll 1
        for (int seg = 0; seg < 2; ++seg) { const int rowbase = seg ? b * SEQ : NLAT + b * CTXL, L = seg ? SEQ : CTXL, per = L >> 6; const int ta = tg * per;
            const bf16* zp = Z_ + (size_t)rowbase * ZP + C_RX + ch; bf16* xp = XR_ + (size_t)rowbase * 256 + ch;
            v4u rm2 = ta >= 2 ? *(const v4u*)(zp + (size_t)(ta - 2) * ZP) : zero, rm1 = ta >= 1 ? *(const v4u*)(zp + (size_t)(ta - 1) * ZP) : zero, r0 = *(const v4u*)(zp + (size_t)ta * ZP);
#pragma unroll 1
            for (int t = ta; t < ta + per; t += 4) {
                const v4u n0 = (t + 1 < L) ? *(const v4u*)(zp + (size_t)(t + 1) * ZP) : zero, n1 = (t + 2 < L) ? *(const v4u*)(zp + (size_t)(t + 2) * ZP) : zero,
                          n2 = (t + 3 < L) ? *(const v4u*)(zp + (size_t)(t + 3) * ZP) : zero, n3 = (t + 4 < L) ? *(const v4u*)(zp + (size_t)(t + 4) * ZP) : zero;
                lru_conv_out(rm2, rm1, r0, n0, w0, w1, cb0, cb1, xp + (size_t)t * 256);
                lru_conv_out(rm1, r0, n0, n1, w0, w1, cb0, cb1, xp + (size_t)(t + 1) * 256);
                lru_conv_out(r0, n0, n1, n2, w0, w1, cb0, cb1, xp + (size_t)(t + 2) * 256);
                lru_conv_out(n0, n1, n2, n3, w0, w1, cb0, cb1, xp + (size_t)(t + 3) * 256);
                rm2 = n1; rm1 = n2; r0 = n3; } }
    }
    VM_WAIT(); __syncthreads();
    if (wave >= 4) return;
    const bf16* const LRUW_ = (const bf16*)(F.ws + WS_LRUW);
    const int d = __builtin_amdgcn_readfirstlane(wave >> 1), nt = __builtin_amdgcn_readfirstlane(wave & 1);
    const int r32 = lane & 31, hi = lane >> 5; const int c = 64 * j + 32 * nt + r32;
    bf16x8 Wr[4], Wi[4], Id[4];
    { const bf16* lw = LRUW_ + ((size_t)((((l * 2 + d) * 4 + j) * 2 + 0) * 2 + nt) * 4) * 64 * 8;
#pragma unroll
      for (int s = 0; s < 4; ++s) { Wr[s] = *(const bf16x8*)(lw + (s * 64 + lane) * 8); Wi[s] = *(const bf16x8*)(lw + 2 * 4 * 64 * 8 + (s * 64 + lane) * 8);
#pragma unroll
          for (int e = 0; e < 8; ++e) Id[s][e] = (16 * s + 8 * hi + e == 32 * nt + r32) ? (short)0x3F80 : (short)0; } }
    const float brv = inptr(16)[(l * 2 + d) * 256 + c], biv = inptr(18)[(l * 2 + d) * 256 + c];
    const float lam = inptr(19)[(l * 2 + d) * 256 + c]; const float ka = 8.0f * 1.4426950408889634f * log1pf(expf(-lam));
    const int ocol = (d ? C_HB : C_HF) + c;
    constexpr int NTC = CTXL / 32, NTL = SEQ / 32, NTT = NTC + NTL;
#define LRU_ROW0(ti) ((ti) < NTC ? NLAT + b * CTXL + 32 * (d ? NTC - 1 - (ti) : (ti)) : b * SEQ + 32 * (d ? NTL - 1 - ((ti) - NTC) : (ti) - NTC))
    bf16x8 An[4]; bf16 gn[16];
    { const int row0 = LRU_ROW0(0); const bf16* ap = XR_ + (size_t)(row0 + r32) * 256 + 64 * j + 8 * hi;
#pragma unroll
      for (int s = 0; s < 4; ++s) An[s] = *(const bf16x8*)(ap + 16 * s);
      const bf16* gp = Z_ + (size_t)(row0 + 4 * hi) * ZP + C_RG + c;
#pragma unroll
      for (int e = 0; e < 16; ++e) gn[e] = gp[(size_t)((e & 3) + 8 * (e >> 2)) * ZP]; }
    float carry = 0.f;
#pragma unroll 1
    for (int ti = 0; ti < NTT; ++ti) {
        const int row0 = LRU_ROW0(ti);
        bf16x8 A[4]; bf16 gt[16];
#pragma unroll
        for (int s = 0; s < 4; ++s) A[s] = An[s];
#pragma unroll
        for (int e = 0; e < 16; ++e) gt[e] = gn[e];
        { const int tn = ti + 1 < NTT ? ti + 1 : ti; const int rown = LRU_ROW0(tn); const bf16* ap = XR_ + (size_t)(rown + r32) * 256 + 64 * j + 8 * hi;
#pragma unroll
          for (int s = 0; s < 4; ++s) An[s] = *(const bf16x8*)(ap + 16 * s);
          const bf16* gp = Z_ + (size_t)(rown + 4 * hi) * ZP + C_RG + c;
#pragma unroll
          for (int e = 0; e < 16; ++e) gn[e] = gp[(size_t)((e & 3) + 8 * (e >> 2)) * ZP]; }
        f32x16 ar, ai, ax;
#pragma unroll
        for (int e = 0; e < 16; ++e) { ar[e] = 0.f; ai[e] = 0.f; ax[e] = 0.f; }
#pragma unroll
        for (int s = 0; s < 4; ++s) { ar = __builtin_amdgcn_mfma_f32_32x32x16_bf16(A[s], Wr[s], ar, 0, 0, 0); ai = __builtin_amdgcn_mfma_f32_32x32x16_bf16(A[s], Wi[s], ai, 0, 0, 0);
            ax = __builtin_amdgcn_mfma_f32_32x32x16_bf16(A[s], Id[s], ax, 0, 0, 0); }
        float av[16], bx[16];
#pragma unroll
        for (int e = 0; e < 16; ++e) { const float rr = __builtin_amdgcn_rcpf(1.f + __builtin_amdgcn_exp2f(-1.4426950408889634f * (ar[e] + brv)));
            const float ii = __builtin_amdgcn_rcpf(1.f + __builtin_amdgcn_exp2f(-1.4426950408889634f * (ai[e] + biv)));
            const float a = __builtin_amdgcn_exp2f(-ka * rr); av[e] = a; bx[e] = __builtin_amdgcn_sqrtf(fmaxf(1.f - a * a, 0.f)) * ii * ax[e]; }
        float hl[16], pl[16], Pk[4], Sk[4];
        if (d == 0) {
#pragma unroll
            for (int k = 0; k < 4; ++k) { float S = 0.f, P = 1.f;
#pragma unroll
                for (int e = 0; e < 4; ++e) { const int i = 4 * k + e; S = av[i] * S + bx[i]; P *= av[i]; hl[i] = S; pl[i] = P; } Pk[k] = P; Sk[k] = S; }
        } else {
#pragma unroll
            for (int k = 0; k < 4; ++k) { float S = 0.f, P = 1.f;
#pragma unroll
                for (int e = 3; e >= 0; --e) { const int i = 4 * k + e; S = av[i] * S + bx[i]; P *= av[i]; hl[i] = S; pl[i] = P; } Pk[k] = P; Sk[k] = S; }
        }
        float cin[4]; float cc = carry;
        if (d == 0) {
#pragma unroll
            for (int k = 0; k < 4; ++k) { const float Pp = __shfl_xor(Pk[k], 32), Sp = __shfl_xor(Sk[k], 32);
                const float P0 = hi ? Pp : Pk[k], S0 = hi ? Sp : Sk[k], P1 = hi ? Pk[k] : Pp, S1 = hi ? Sk[k] : Sp;
                const float c0 = cc; cc = P0 * cc + S0; const float c1 = cc; cc = P1 * cc + S1; cin[k] = hi ? c1 : c0; }
        } else {
#pragma unroll
            for (int k = 3; k >= 0; --k) { const float Pp = __shfl_xor(Pk[k], 32), Sp = __shfl_xor(Sk[k], 32);
                const float P0 = hi ? Pp : Pk[k], S0 = hi ? Sp : Sk[k], P1 = hi ? Pk[k] : Pp, S1 = hi ? Sk[k] : Sp;
                const float c1 = cc; cc = P1 * cc + S1; const float c0 = cc; cc = P0 * cc + S0; cin[k] = hi ? c1 : c0; }
        }
        carry = cc;
        bf16* zp = Z_ + (size_t)(row0 + 4 * hi) * ZP + ocol;
#pragma unroll
        for (int e = 0; e < 16; ++e) { const float h = hl[e] + pl[e] * cin[e >> 2]; zp[(size_t)((e & 3) + 8 * (e >> 2)) * ZP] = (bf16)f2bf(h * bf1(gt[e])); }
    }
#undef LRU_ROW0
}

struct Args { const float* in[23]; float* out; unsigned char* ws; int ph_lo, ph_hi; };
__global__ void __launch_bounds__(NWAVES * 64, 2) mk_fwd(Args args) {
    extern __shared__ __attribute__((aligned(16))) unsigned char lds[];
    Frame F;
    F.lds = (LAS unsigned char*)lds; F.ldsg = lds;
    F.MISC = (volatile LAS unsigned*)(F.lds + MISC_OFF);
    F.tid = threadIdx.x; F.lane = F.tid & 63; F.wave = __builtin_amdgcn_readfirstlane(F.tid >> 6);
    F.G = gridDim.x; F.bid = blockIdx.x;
    unsigned char* ws = args.ws;
    F.ws = ws; F.ctl = (gu32*)(ws + WS_CTL);
    for (int u = F.tid; u < (LDS_BYTES - LDSCTL_OFF) / 4; u += NWAVES * 64) ((LAS unsigned*)(F.lds + LDSCTL_OFF))[u] = 0u;
    __syncthreads();
    XcdBarrier bar; bar.bar = (unsigned*)(F.ctl + CW_BAR); bar.x = 0; bar.st = nullptr;
    const int lo = args.ph_lo, hi = args.ph_hi;
    if (hi - lo > 1) bar = xcd_barrier_post((unsigned*)(F.ctl + CW_BAR), F.MISC + 8);
#ifndef PROBE_MASK
#define PROBE_MASK 0u
#endif
#ifndef PROBE_MULT
#define PROBE_MULT 8
#endif
    unsigned long long t_prev = 0ull, t_acc = 0ull, t_unit = 0ull; (void)t_unit;
    if (PROBE_MASK != 0u) t_prev = __builtin_amdgcn_s_memrealtime();
#define STAMP(k) do { if (PROBE_MASK != 0u) { const unsigned long long t_now = __builtin_amdgcn_s_memrealtime(); if ((PROBE_MASK >> (k)) & 1u) t_acc += t_now - t_prev; t_prev = t_now; } } while (0)
#define IN(k) (lo <= (k) && (k) < hi)
#define SEAM(k) do { if (IN(k) && IN((k) + 1)) xcd_barrier(bar); } while (0)

    if (IN(0)) { p0a(F); SEAM(0); STAMP(0); }
    if (IN(1)) { p0b(F); SEAM(1); STAMP(1); }
#pragma unroll 1
    for (int l = 0; l < DEPTH; ++l) {
        const int pb = 2 + 4 * l; const bool last = (l == DEPTH - 1);
        if (IN(pb)) {
            pg8::Gemm g{(const bf16*)(ws + WS_XM), (const bf16*)(ws + WS_WIN) + (size_t)l * DIN * DMODEL, MROWS, DIN, DMODEL, DMODEL}; pg8::StaticOrder S; S.init(MROWS, DIN, F.G, F.bid);
            pg8::Epi1 E{(bf16*)(ws + WS_Z), inptr(11) + l * 64, inptr(12) + l * 64, (const float*)(ws + WS_ROPE)};
            pg8::gemm_phase<pg8::Epi1, pg8::StaticOrder, true, true>(F.lds + RING_OFF, g, S, E);
            SEAM(pb); STAMP(pb);
        }
        if (IN(pb + 1)) {
            const int n_attc = last ? 0 : 128, n_g = last ? 256 : 288; const int o_attl = 64, o_attc = o_attl + 1024, o_g = o_attc + n_attc, total = o_g + n_g;
            gu32* head = F.ctl + CW_Q + 64 * l;
            for (;;) {
                if (F.tid == 0) F.MISC[0] = __hip_atomic_fetch_add((unsigned*)head, 1u, RLX_AGENT);
                __syncthreads(); const int unit = (int)F.MISC[0]; __syncthreads();
                if (unit >= total) break;
#if defined(PROBE_UNIT_KIND)
                const unsigned long long tu0 = __builtin_amdgcn_s_memrealtime(); const int ukind = unit < o_attl ? 1 : unit < o_attc ? 2 : unit < o_g ? 3 : 4;
#endif
                if (unit < o_attl) lru_unit(F, l, unit >> 2, unit & 3);
                else if (unit < o_attc) { const int a = unit - o_attl; const int b = a >> 6, kvh = (a >> 5) & 1, qb = (a >> 2) & 7, h = kvh * 4 + (a & 3);
                    const attn_body::bf16* Zb = (const attn_body::bf16*)(ws + WS_Z);
                    attn_body::attn_unit<8>(Zb + (size_t)(b * SEQ + qb * 256) * ZP + C_Q + h * 64, Zb + (size_t)(b * SEQ) * ZP + C_K + kvh * 64, Zb + (size_t)(NLAT + b * CTXL) * ZP + C_K + kvh * 64, 32, 36, (char*)F.ldsg + RING_OFF); }
                else if (unit < o_g) { const int a = unit - o_attc; const int b = a >> 3, h = a & 7;
                    const attn_body::bf16* Zb = (const attn_body::bf16*)(ws + WS_Z); const attn_body::bf16* kc = Zb + (size_t)(NLAT + b * CTXL) * ZP + C_K + (h >> 2) * 64;
                    attn_body::attn_unit<8>(Zb + (size_t)(NLAT + b * CTXL) * ZP + C_Q + h * 64, kc, kc, 4, 4, (char*)F.ldsg + RING_OFF); }
                else gmlp_unit(F, l, unit - o_g);
#if defined(PROBE_UNIT_KIND)
                if (ukind == PROBE_UNIT_KIND && l == PROBE_LAYER) t_unit += __builtin_amdgcn_s_memrealtime() - tu0;
#endif
            }
            SEAM(pb + 1); STAMP(pb + 1);
        }
        if (IN(pb + 2)) {
            const int M3 = last ? NLAT : MROWS;
            pg8::Gemm g{(const bf16*)(ws + WS_Z), (const bf16*)(ws + WS_WO) + (size_t)l * DMODEL * K2, M3, DMODEL, K2, ZP}; pg8::StaticOrder S; S.init(M3, DMODEL, F.G, F.bid);
            pg8::Epi2 E{inptr(0), inptr(2), (float*)(ws + WS_XT), (const float*)(ws + WS_MODS) + (size_t)l * 17 * 3072, l == 0 ? 1 : 0};
            pg8::gemm_phase<pg8::Epi2, pg8::StaticOrder, true, true>(F.lds + RING_OFF, g, S, E);
            SEAM(pb + 2); STAMP(pb + 2);
        }
        if (IN(pb + 3)) { p4_ln(F, l); SEAM(pb + 3); STAMP(pb + 3); }
    }
#if defined(PROBE_UNIT_KIND)
    if (threadIdx.x == 0) { const unsigned long long t0 = __builtin_amdgcn_s_memrealtime(); while (__builtin_amdgcn_s_memrealtime() - t0 < (unsigned long long)PROBE_MULT * t_unit) __builtin_amdgcn_s_sleep(8); }
#endif
    if (PROBE_MASK != 0u && blockIdx.x == 0 && threadIdx.x == 0) { const unsigned long long t0 = __builtin_amdgcn_s_memrealtime(); while (__builtin_amdgcn_s_memrealtime() - t0 < (unsigned long long)PROBE_MULT * t_acc) __builtin_amdgcn_s_sleep(8); }
#undef IN
#undef STAMP
#undef SEAM
}

extern "C" void kernel_launch(void* const* d_in, const int* in_sizes, int n_in, void* d_out, int out_size, void* d_ws, size_t ws_size, hipStream_t stream) {
    static int grid = 0;
    if (grid == 0) {
        if (n_in != 23 || out_size != NLAT * DMODEL || ws_size < WS_END) { fprintf(stderr, "kernel_launch: unexpected shapes (n_in %d out %d ws %zu, need %zu); nothing launched\n", n_in, out_size, ws_size, (size_t)WS_END); grid = -1; return; }
        int dev = 0, cus = 0;
        if (hipGetDevice(&dev) != hipSuccess || hipDeviceGetAttribute(&cus, hipDeviceAttributeMultiprocessorCount, dev) != hipSuccess) { grid = -1; return; }
        if (hipFuncSetAttribute((const void*)mk_fwd, hipFuncAttributeMaxDynamicSharedMemorySize, LDS_BYTES) != hipSuccess) { fprintf(stderr, "kernel_launch: hipFuncSetAttribute failed\n"); grid = -1; return; }
        int per_cu = 0; (void)hipOccupancyMaxActiveBlocksPerMultiprocessor(&per_cu, (const void*)mk_fwd, NWAVES * 64, LDS_BYTES); (void)hipGetLastError();
        grid = cus;
    }
    if (grid < 0) return;
    if (hipMemsetAsync((char*)d_ws + WS_CTL, 0, CTL_ZERO_BYTES, stream) != hipSuccess) return;
    Args a{};
    for (int i = 0; i < 23; ++i) a.in[i] = (const float*)d_in[i];
    a.out = (float*)d_out; a.ws = (unsigned char*)d_ws;
#if MK_PER_PHASE
    for (int p = 0; p < NPHASE; ++p) { a.ph_lo = p; a.ph_hi = p + 1; hipLaunchKernelGGL(mk_fwd, dim3(grid), dim3(NWAVES * 64), LDS_BYTES, stream, a); }
#else
    a.ph_lo = 0; a.ph_hi = NPHASE;
    hipLaunchKernelGGL(mk_fwd, dim3(grid), dim3(NWAVES * 64), LDS_BYTES, stream, a);
#endif
}
```

```cpp
#include <hip/hip_runtime.h>
#include <hip/hip_bf16.h>
#include <cstdio>
#include <cstdint>
#include <cmath>

constexpr int DMODEL = 1024, NBATCH = 16, SEQ = 2048, CTXL = 256, DEPTH = 4;
constexpr int NLAT = NBATCH * SEQ, NCTXR = NBATCH * CTXL, MROWS = NLAT + NCTXR;
constexpr int DIN = 2560;
constexpr int ZP = 3072;
constexpr int C_MA = 0, C_Q = 256, C_HF = 768, C_HB = 1024, C_VA = 1280, C_GA = 1536, C_K = 1792, C_V = 1920, C_GB = 2048, C_RX = 2560, C_RG = 2816;
constexpr int K2 = 1280;
constexpr float ALPHA = 1.681792830507429f;
constexpr float QSCALE = 0.125f * 1.4426950408889634f;

namespace pg8 {
#define PG8_LAS __attribute__((address_space(3)))
typedef unsigned short bf16_t;
typedef short bf16x8 __attribute__((ext_vector_type(8)));
typedef float f32x4 __attribute__((ext_vector_type(4)));
typedef unsigned u32x4 __attribute__((ext_vector_type(4)));
constexpr int BM = 256, BK = 64, HALF = 128, HTB = HALF * BK * 2, STAGE_BYTES = 8 * HTB, NXCD = 8, WGM = 8;

__host__ __device__ __forceinline__ int lds_byte(int r, int c) { const int st = (r >> 4) * 2 + (c >> 5), rr = r & 15, cc = c & 31, ob = rr * 64 + cc * 2; return st * 1024 + (ob ^ (((ob >> 9) & 1) << 5)); }
__host__ __device__ __forceinline__ void stage_rc(int b, int& R, int& C) { const int st = b / 1024, sb = b % 1024, swz = sb ^ (((sb >> 9) & 1) << 5); R = (st >> 1) * 16 + swz / 64; C = (st & 1) * 32 + (swz % 64) / 2; }
__host__ __device__ __forceinline__ int perm32(int rho) { const int n = rho >> 4, i = rho & 15; return 8 * (i >> 2) + 4 * n + (i & 3); }

struct Unit { int pm, pn; };
struct Gemm { const bf16_t* A; const bf16_t* Bt; int M, N, K, lda; };

struct StaticOrder {
    int nM, nN, nwg, G, c;
    __host__ __device__ void init(int M, int N, int G_, int c_) { nM = M / BM; nN = N / BM; nwg = nM * nN; G = G_; c = c_; }
    __host__ __device__ bool next(int i, Unit& u) const {
        const long L = (long)i * G + c; if (L >= nwg) return false;
        int wgid = (int)L; { const int q = nwg / NXCD, r = nwg % NXCD, xcd = wgid % NXCD, off = wgid / NXCD; wgid = (xcd < r ? xcd * (q + 1) : r * (q + 1) + (xcd - r) * q) + off; }
        const int nig = WGM * nN, gid = wgid / nig, fm = gid * WGM, gsz = (nM - fm) < WGM ? (nM - fm) : WGM;
        u.pm = fm + ((wgid % nig) % gsz); u.pn = (wgid % nig) / gsz; return true;
    }
    __device__ __forceinline__ void a_ready(const Unit&) const {}
    __device__ __forceinline__ void done(const Unit&) const {}
};

__device__ __forceinline__ unsigned cvt_pk_bf16(float lo, float hi) { unsigned r; asm volatile("v_cvt_pk_bf16_f32 %0, %1, %2" : "=v"(r) : "v"(lo), "v"(hi)); return r; }
__device__ __forceinline__ float fast_gelu(float x) {
    const float u = 0.7978845608028654f * (x + 0.044715f * x * x * x);
    return x * __builtin_amdgcn_rcpf(1.f + __builtin_amdgcn_exp2f(-2.8853900817779268f * u));
}
__device__ __forceinline__ float fast_silu(float x) { return x * __builtin_amdgcn_rcpf(1.f + __builtin_amdgcn_exp2f(-1.4426950408889634f * x)); }

struct Epi1 {
    static constexpr bool PERM = true, AFTER_DRAIN = false;
    bf16_t* Z; const float* qg; const float* kg; const float* rope;
    __device__ __forceinline__ void operator()(const f32x4 (&acc)[2][2][4][2], const Unit& u, int wr, int wc, int fr, int fq) const {
        asm volatile("" : "+v"(fr), "+v"(fq));
        const int pn = u.pn; const int row0 = u.pm * BM + wr * 64 + fr;
        const bool qk = (pn == 3) || (pn == 4) || (pn == 5 && wc < 2);
        if (qk) {
            const float* g = (pn == 5) ? kg : qg; const float sc = (pn == 5) ? 1.f : QSCALE;
            const int dst = (pn == 5) ? (C_K + wc * 64) : (C_Q + (wc + 4 * (pn - 3)) * 64);
            f32x4 gw[2][2];
#pragma unroll
            for (int bj = 0; bj < 2; ++bj)
#pragma unroll
                for (int n = 0; n < 2; ++n) gw[bj][n] = *(const f32x4*)(g + 32 * bj + 16 * n + 4 * fq) * sc;
            const bool lat = u.pm < 128;
#pragma unroll
            for (int ai = 0; ai < 2; ++ai)
#pragma unroll
                for (int m = 0; m < 4; ++m) {
                    const int r = row0 + ai * HALF + m * 16;
                    float ss = 0.f;
#pragma unroll
                    for (int bj = 0; bj < 2; ++bj)
#pragma unroll
                        for (int n = 0; n < 2; ++n) { const f32x4 x = acc[ai][bj][m][n]; ss += (x[0] * x[0] + x[1] * x[1]) + (x[2] * x[2] + x[3] * x[3]); }
                    ss += __shfl_xor(ss, 16); ss += __shfl_xor(ss, 32);
                    const float rms = __builtin_amdgcn_rsqf(ss * (1.f / 64.f) + 1e-6f);
                    const int t = r & 2047;
                    bf16_t* zr = Z + (size_t)r * ZP + dst + 8 * fq;
#pragma unroll
                    for (int bj = 0; bj < 2; ++bj) {
                        const f32x4 x1 = acc[ai][bj][m][0] * rms * gw[bj][0], x2 = acc[ai][bj][m][1] * rms * gw[bj][1];
                        f32x4 o1 = x1, o2 = x2;
                        if (lat) { const int pos = bj ? (t & 63) : (t >> 6);
                            const f32x4 cs = *(const f32x4*)(rope + pos * 16 + 4 * fq), sn = *(const f32x4*)(rope + 1024 + pos * 16 + 4 * fq);
                            o1 = x1 * cs - x2 * sn; o2 = x1 * sn + x2 * cs; }
                        u32x4 w; w.x = cvt_pk_bf16(o1[0], o1[1]); w.y = cvt_pk_bf16(o1[2], o1[3]); w.z = cvt_pk_bf16(o2[0], o2[1]); w.w = cvt_pk_bf16(o2[2], o2[3]);
                        *(u32x4*)(zr + 32 * bj) = w;
                    }
                    asm volatile("" ::: "memory");
                }
        } else {
            int zb = 0, act = 0, bstep = HALF;
            if (pn == 0) { zb = C_MA; act = 1; } else if (pn == 1) { zb = C_VA; act = 1; } else if (pn == 2) { zb = C_GA; act = 2; }
            else if (pn == 5) { zb = C_V + (wc - 2) * 64 - wc * 32; act = 0; bstep = 32; }
            else if (pn == 6) { zb = C_GB; act = 2; } else if (pn == 7) { zb = C_GB + 256; act = 2; } else if (pn == 8) { zb = C_RX; act = 0; } else { zb = C_RG; act = 2; }
            const int col0 = zb + wc * 32 + 8 * fq;
#pragma unroll
            for (int ai = 0; ai < 2; ++ai)
#pragma unroll
                for (int m = 0; m < 4; ++m) {
                    bf16_t* zr = Z + (size_t)(row0 + ai * HALF + m * 16) * ZP + col0;
#pragma unroll
                    for (int bj = 0; bj < 2; ++bj) {
                        f32x4 v0 = acc[ai][bj][m][0], v1 = acc[ai][bj][m][1];
                        if (act == 1) {
#pragma unroll
                            for (int e = 0; e < 4; ++e) { v0[e] = fast_gelu(v0[e]); v1[e] = fast_gelu(v1[e]); }
                        } else if (act == 2) {
#pragma unroll
                            for (int e = 0; e < 4; ++e) { v0[e] = fast_silu(v0[e]); v1[e] = fast_silu(v1[e]); }
                        }
                        u32x4 w; w.x = cvt_pk_bf16(v0[0], v0[1]); w.y = cvt_pk_bf16(v0[2], v0[3]); w.z = cvt_pk_bf16(v1[0], v1[1]); w.w = cvt_pk_bf16(v1[2], v1[3]);
                        *(u32x4*)(zr + bj * bstep) = w;
                    }
                }
        }
    }
};
struct Epi2 {
    static constexpr bool PERM = false, AFTER_DRAIN = false;
    const float* xin; const float* ctxin; float* XT; const float* mods_l; int layer0;
    __device__ __forceinline__ void operator()(const f32x4 (&acc)[2][2][4][2], const Unit& u, int wr, int wc, int fr, int fq) const {
        asm volatile("" : "+v"(fr), "+v"(fq));
        const int row0 = u.pm * BM + wr * 64 + fr, col0 = u.pn * BM + wc * 32 + 4 * fq;
        const int mrow = u.pm < 128 ? (u.pm >> 3) : 16;
        const float* gp = mods_l + mrow * 3072 + 2048 + col0;
        f32x4 gv[2][2];
#pragma unroll
        for (int bj = 0; bj < 2; ++bj)
#pragma unroll
            for (int n = 0; n < 2; ++n) gv[bj][n] = *(const f32x4*)(gp + bj * HALF + n * 16);
#pragma unroll
        for (int ai = 0; ai < 2; ++ai)
#pragma unroll
            for (int m = 0; m < 4; ++m) {
                const int r = row0 + ai * HALF + m * 16;
                const float* src = layer0 ? (r < NLAT ? xin + (size_t)r * DMODEL : ctxin + (size_t)(r - NLAT) * DMODEL) : XT + (size_t)r * DMODEL;
                float* dstp = XT + (size_t)r * DMODEL + col0; src += col0;
#pragma unroll
                for (int bj = 0; bj < 2; ++bj)
#pragma unroll
                    for (int n = 0; n < 2; ++n) { const f32x4 x = *(const f32x4*)(src + bj * HALF + n * 16); *(f32x4*)(dstp + bj * HALF + n * 16) = x * ALPHA + gv[bj][n] * acc[ai][bj][m][n]; }
                if (m & 1) asm volatile("" ::: "memory");
            }
    }
};
template <class Epi, class Sched, bool ALIGN_EPI = false, bool SP2 = false>
__device__ __forceinline__ void gemm_phase(PG8_LAS unsigned char* lds, const Gemm g, const Sched& S, const Epi& E) {
    int tid_ = threadIdx.x; asm volatile("" : "+v"(tid_));
    const int tid = tid_, wid = __builtin_amdgcn_readfirstlane(tid >> 6), lane = tid & 63, wr = wid >> 2, wc = wid & 3, fr = lane & 15, fq = lane >> 4;
    const int K = g.K, nt = K / BK;
    unsigned voffA[2], voffB[2];
#pragma unroll
    for (int i = 0; i < 2; ++i) { int R, C; stage_rc(tid * 16 + i * 8192, R, C); const int Rb = Epi::PERM ? ((R & ~31) + perm32(R & 31)) : R;
        voffA[i] = (unsigned)(R * g.lda + C) * 2u; voffB[i] = (unsigned)(Rb * K + C) * 2u; }
    const size_t kstep = (size_t)(BK * 2);
    const size_t hstepA = (size_t)HALF * g.lda * 2, hstepB = (size_t)HALF * K * 2;
    const size_t tstepA = 2 * hstepA, tstepB = 2 * hstepB;
    const unsigned ldsw = (unsigned)wid * 1024u;
    const int aoff = lds_byte(wr * 64 + fr, fq * 8), boff = lds_byte(wc * 32 + fr, fq * 8);
#define PG8_SA(b, h) (((b) * 2 + (h)) * HTB)
#define PG8_SB(b, h) ((4 + (b) * 2 + (h)) * HTB)
#define PG8_STAGE(bufoff, gbase, voff) do { _Pragma("unroll") for (int _i = 0; _i < 2; ++_i) \
        __builtin_amdgcn_global_load_lds((const unsigned*)((const char*)(gbase) + (voff)[_i]), (PG8_LAS unsigned*)(lds + (bufoff) + ldsw + _i * 8192), 16, 0, 0); } while (0)
#define PG8_LDA(dst, b, h) do { _Pragma("unroll") for (int m = 0; m < 4; ++m) _Pragma("unroll") for (int k = 0; k < 2; ++k) dst[m][k] = *(const PG8_LAS bf16x8*)(lds + PG8_SA(b, h) + aoff + m * 2048 + k * 1024); } while (0)
#define PG8_LDB(dst, b, h) do { _Pragma("unroll") for (int n = 0; n < 2; ++n) _Pragma("unroll") for (int k = 0; k < 2; ++k) dst[n][k] = *(const PG8_LAS bf16x8*)(lds + PG8_SB(b, h) + boff + n * 2048 + k * 1024); } while (0)
#define PG8_MMA(ai, bj, At, Bt) do { __builtin_amdgcn_s_setprio(1); _Pragma("unroll") for (int m = 0; m < 4; ++m) _Pragma("unroll") for (int n = 0; n < 2; ++n) _Pragma("unroll") for (int k = 0; k < 2; ++k) \
        acc[ai][bj][m][n] = __builtin_amdgcn_mfma_f32_16x16x32_bf16(Bt[n][k], At[m][k], acc[ai][bj][m][n], 0, 0, 0); __builtin_amdgcn_s_setprio(0); } while (0)
#define PG8_WAIT_V(n) asm volatile("s_waitcnt vmcnt(" #n ")" ::: "memory")
#define PG8_WAIT_L(n) asm volatile("s_waitcnt lgkmcnt(" #n ")" ::: "memory")
#define PG8_BAR __builtin_amdgcn_s_barrier()
#define PG8_SCHED __builtin_amdgcn_sched_barrier(0)
    Unit cur, nxt; int ui = 0;
    if (!S.next(0, cur)) return;
    f32x4 acc[2][2][4][2];
#pragma unroll
    for (int a = 0; a < 2; ++a)
#pragma unroll
        for (int b = 0; b < 2; ++b)
#pragma unroll
            for (int m = 0; m < 4; ++m)
#pragma unroll
                for (int n = 0; n < 2; ++n) acc[a][b][m][n] = (f32x4){0.f, 0.f, 0.f, 0.f};
    bf16x8 At[4][2], B0[2][2], B1[2][2];
    const char* cA = (const char*)g.A + (size_t)cur.pm * tstepA; const char* cB = (const char*)g.Bt + (size_t)cur.pn * tstepB;
    S.a_ready(cur);
    if constexpr (SP2) {
        PG8_STAGE(PG8_SB(0, 0), cB, voffB); PG8_STAGE(PG8_SB(0, 1), cB + hstepB, voffB); PG8_STAGE(PG8_SA(0, 0), cA, voffA); PG8_STAGE(PG8_SA(0, 1), cA + hstepA, voffA);
        if (wr == 1) PG8_BAR;
        PG8_WAIT_V(2); PG8_BAR;
        PG8_STAGE(PG8_SB(1, 0), cB + kstep, voffB); PG8_STAGE(PG8_SA(1, 0), cA + kstep, voffA); PG8_STAGE(PG8_SB(1, 1), cB + hstepB + kstep, voffB);
        PG8_WAIT_V(6); PG8_BAR;
    } else {
        PG8_STAGE(PG8_SB(0, 0), cB, voffB); PG8_STAGE(PG8_SA(0, 0), cA, voffA); PG8_STAGE(PG8_SB(0, 1), cB + hstepB, voffB); PG8_STAGE(PG8_SA(0, 1), cA + hstepA, voffA);
        if (wr == 1) PG8_BAR;
        PG8_WAIT_V(4); PG8_BAR;
        PG8_STAGE(PG8_SB(1, 0), cB + kstep, voffB); PG8_STAGE(PG8_SA(1, 0), cA + kstep, voffA); PG8_STAGE(PG8_SB(1, 1), cB + hstepB + kstep, voffB);
        PG8_WAIT_V(6); PG8_BAR;
    }
    for (;;) {
        const bool has_next = S.next(ui + 1, nxt);
        const char* nA = has_next ? (const char*)g.A + (size_t)nxt.pm * tstepA : cA; const char* nB = has_next ? (const char*)g.Bt + (size_t)nxt.pn * tstepB : cB;
        for (int t = 0; t < nt; t += 2) {
            const bool last = (t == nt - 2);
            const char* a1 = cA + (size_t)(t + 1) * kstep;
            const char* a2 = last ? nA : cA + (size_t)(t + 2) * kstep; const char* b2 = last ? nB : cB + (size_t)(t + 2) * kstep;
            const char* a3 = a2 + kstep; const char* b3 = b2 + kstep;
            if (last && has_next) S.a_ready(nxt);
            if constexpr (SP2) {
            PG8_LDB(B0, 0, 0); PG8_LDB(B1, 0, 1); PG8_SCHED; PG8_LDA(At, 0, 0); PG8_STAGE(PG8_SA(1, 1), a1 + hstepA, voffA);
            PG8_WAIT_V(8); PG8_WAIT_L(0); PG8_BAR; PG8_MMA(0, 0, At, B0); PG8_MMA(0, 1, At, B1); PG8_BAR; PG8_SCHED;
            PG8_LDA(At, 0, 1); PG8_STAGE(PG8_SB(0, 0), b2, voffB); PG8_STAGE(PG8_SB(0, 1), b2 + hstepB, voffB); PG8_STAGE(PG8_SA(0, 0), a2, voffA);
            PG8_WAIT_V(8); PG8_WAIT_L(0); PG8_BAR; PG8_MMA(1, 0, At, B0); PG8_MMA(1, 1, At, B1); PG8_BAR; PG8_SCHED;
            PG8_LDB(B0, 1, 0); PG8_LDB(B1, 1, 1); PG8_SCHED; PG8_LDA(At, 1, 0); PG8_STAGE(PG8_SA(0, 1), a2 + hstepA, voffA);
            PG8_WAIT_V(8); PG8_WAIT_L(0); PG8_BAR; PG8_MMA(0, 0, At, B0); PG8_MMA(0, 1, At, B1); PG8_BAR; PG8_SCHED;
            PG8_LDA(At, 1, 1); PG8_STAGE(PG8_SB(1, 0), b3, voffB); PG8_STAGE(PG8_SB(1, 1), b3 + hstepB, voffB); PG8_STAGE(PG8_SA(1, 0), a3, voffA);
            PG8_WAIT_V(8); PG8_WAIT_L(0); PG8_BAR; PG8_MMA(1, 0, At, B0); PG8_MMA(1, 1, At, B1); PG8_BAR; PG8_SCHED;
            } else {
            PG8_LDB(B0, 0, 0); PG8_SCHED; PG8_LDA(At, 0, 0); PG8_STAGE(PG8_SA(1, 1), a1 + hstepA, voffA);
            PG8_WAIT_L(8); PG8_BAR; PG8_WAIT_L(0); PG8_MMA(0, 0, At, B0); PG8_BAR; PG8_SCHED;
            PG8_LDB(B1, 0, 1); PG8_STAGE(PG8_SB(0, 0), b2, voffB);
            PG8_BAR; PG8_WAIT_L(0); PG8_MMA(0, 1, At, B1); PG8_BAR;
            PG8_LDA(At, 0, 1); PG8_STAGE(PG8_SA(0, 0), a2, voffA);
            PG8_BAR; PG8_WAIT_L(0); PG8_MMA(1, 0, At, B0); PG8_BAR; PG8_SCHED;
            PG8_STAGE(PG8_SB(0, 1), b2 + hstepB, voffB);
            PG8_WAIT_V(6); PG8_BAR; PG8_MMA(1, 1, At, B1); PG8_BAR;
            PG8_LDB(B0, 1, 0); PG8_SCHED; PG8_LDA(At, 1, 0); PG8_STAGE(PG8_SA(0, 1), a2 + hstepA, voffA);
            PG8_WAIT_L(8); PG8_BAR; PG8_WAIT_L(0); PG8_MMA(0, 0, At, B0); PG8_BAR; PG8_SCHED;
            PG8_LDB(B1, 1, 1); PG8_STAGE(PG8_SB(1, 0), b3, voffB);
            PG8_BAR; PG8_WAIT_L(0); PG8_MMA(0, 1, At, B1); PG8_BAR;
            PG8_LDA(At, 1, 1); PG8_STAGE(PG8_SA(1, 0), a3, voffA);
            PG8_BAR; PG8_WAIT_L(0); PG8_MMA(1, 0, At, B0); PG8_BAR; PG8_SCHED;
            PG8_STAGE(PG8_SB(1, 1), b3 + hstepB, voffB);
            PG8_WAIT_V(6); PG8_BAR; PG8_MMA(1, 1, At, B1); PG8_BAR;
            }
        }
        if constexpr (ALIGN_EPI) { if (wr == 0) PG8_BAR; }
        if constexpr (!Epi::AFTER_DRAIN) { E(acc, cur, wr, wc, fr, fq); S.done(cur); }
        if (!has_next) break;
#pragma unroll
        for (int a = 0; a < 2; ++a)
#pragma unroll
            for (int b = 0; b < 2; ++b)
#pragma unroll
                for (int m = 0; m < 4; ++m)
#pragma unroll
                    for (int n = 0; n < 2; ++n) acc[a][b][m][n] = (f32x4){0.f, 0.f, 0.f, 0.f};
        cur = nxt; cA = nA; cB = nB; ++ui;
        if constexpr (ALIGN_EPI) { if (wr == 1) PG8_BAR; }
    }
    PG8_WAIT_V(0);
    if constexpr (!ALIGN_EPI) { if (wr == 0) PG8_BAR; }
    PG8_BAR;
    if constexpr (Epi::AFTER_DRAIN) { E.fused(acc, cur, wr, wc, fr, fq, lds, wid, lane); S.done(cur); }
#undef PG8_SA
#undef PG8_SB
#undef PG8_STAGE
#undef PG8_LDA
#undef PG8_LDB
#undef PG8_MMA
#undef PG8_WAIT_V
#undef PG8_WAIT_L
#undef PG8_BAR
#undef PG8_SCHED
}
}
namespace attn_body {
using bf16=__hip_bfloat16;
using bf16x8=__attribute__((ext_vector_type(8)))short;
using s16x4=__attribute__((ext_vector_type(4)))short;
using f32x16=__attribute__((ext_vector_type(16)))float;
using u32x4=__attribute__((ext_vector_type(4)))unsigned;
constexpr int D=64,DM=ZP;
constexpr int NW=8,QBLK=32,QB=QBLK*NW,KVBLK=64;
constexpr int ATTN_PITCH=DM, ATTN_UNIT_ROWS=QB;
__device__ __forceinline__ int crow(int r,int hi){return (r&3)+8*(r>>2)+4*hi;}
#define SBAR() __builtin_amdgcn_sched_barrier(0)
__device__ __forceinline__ void cmask(f32x16&p0,f32x16&p1,int jb,int qrel,int hi){
  const float NEG=-INFINITY; int kb=64*jb+4*hi;
  #pragma unroll
  for(int r=0;r<16;++r){int kv=kb+(r&3)+8*(r>>2); if(kv>qrel)p0[r]=NEG; if(kv+32>qrel)p1[r]=NEG;}
}

constexpr int NSLOT=3, SLOTB=8192;
constexpr int LDS_K=0, LDS_V=NSLOT*SLOTB, LDS_WS=2*NSLOT*SLOTB, LDS_OST=LDS_WS+NW*64*4, LDS_BYTES=LDS_OST+NW*4096;
constexpr float C2=0.125f*1.4426950408889634f;
__device__ __forceinline__ void glds16(const void*gsrc,unsigned lds_dst){unsigned keep;
  asm volatile("s_mov_b32 %0, m0\n\ts_mov_b32 m0, %2\n\ts_nop 0\n\tglobal_load_lds_dwordx4 %1, off\n\ts_mov_b32 m0, %0":"=&s"(keep):"v"(gsrc),"s"(lds_dst):"memory");}
__device__ __forceinline__ float max3f(float a,float b,float c){float r;asm("v_max3_f32 %0, %1, %2, %3":"=v"(r):"v"(a),"v"(b),"v"(c));return r;}
__device__ __forceinline__ float max2f(float a,float b){float r;asm("v_max_f32_e32 %0, %1, %2":"=v"(r):"v"(a),"v"(b));return r;}
__device__ __forceinline__ float fadd_s(float a,float b){float r;asm("v_add_f32_e32 %0, %1, %2":"=v"(r):"v"(a),"v"(b));return r;}
__device__ __forceinline__ float fsub_s(float a,float b){float r;asm("v_sub_f32_e32 %0, %1, %2":"=v"(r):"v"(a),"v"(b));return r;}
typedef float f32x2_t __attribute__((ext_vector_type(2))); typedef __bf16 bf16x2_t __attribute__((ext_vector_type(2)));
__device__ __forceinline__ unsigned cvtpk_s(float lo,float hi){f32x2_t v={lo,hi};bf16x2_t b=__builtin_convertvector(v,bf16x2_t);return __builtin_bit_cast(unsigned,b);}
#define WAIT_BAR(N) asm volatile("s_waitcnt vmcnt(" #N ") lgkmcnt(0)\n\ts_barrier":::"memory")

__device__ __forceinline__ void qkt(f32x16&p0,f32x16&p1,const char*Kslot,const bf16x8*qr,const f32x16&negm,int r32,int hi){
  const char*kb=Kslot+hi*1024+r32*16;
  #pragma unroll
  for(int d0=0;d0<4;++d0){
    const bf16x8 b0=*reinterpret_cast<const bf16x8*>(kb+d0*2048);
    const bf16x8 b1=*reinterpret_cast<const bf16x8*>(kb+d0*2048+512);
    if(d0==0){p0=__builtin_amdgcn_mfma_f32_32x32x16_bf16(b0,qr[0],negm,0,0,0);p1=__builtin_amdgcn_mfma_f32_32x32x16_bf16(b1,qr[0],negm,0,0,0);}
    else{p0=__builtin_amdgcn_mfma_f32_32x32x16_bf16(b0,qr[d0],p0,0,0,0);p1=__builtin_amdgcn_mfma_f32_32x32x16_bf16(b1,qr[d0],p1,0,0,0);}}
}
typedef __attribute__((address_space(3))) const char* lds_cptr;
typedef short v4i16_t __attribute__((ext_vector_type(4)));
__device__ __forceinline__ void kload8(bf16x8*kf,lds_cptr kp){
  kf[0]=*(const __attribute__((address_space(3))) bf16x8*)(kp);      kf[1]=*(const __attribute__((address_space(3))) bf16x8*)(kp+512);
  kf[2]=*(const __attribute__((address_space(3))) bf16x8*)(kp+2048); kf[3]=*(const __attribute__((address_space(3))) bf16x8*)(kp+2560);
  kf[4]=*(const __attribute__((address_space(3))) bf16x8*)(kp+4096); kf[5]=*(const __attribute__((address_space(3))) bf16x8*)(kp+4608);
  kf[6]=*(const __attribute__((address_space(3))) bf16x8*)(kp+6144); kf[7]=*(const __attribute__((address_space(3))) bf16x8*)(kp+6656);
}
__device__ __forceinline__ void kload2(bf16x8*kf,lds_cptr kp,int j){ kf[2*j]=*(const __attribute__((address_space(3))) bf16x8*)(kp+j*2048); kf[2*j+1]=*(const __attribute__((address_space(3))) bf16x8*)(kp+j*2048+512); }
__device__ __forceinline__ s16x4 vtr(lds_cptr p){ return __builtin_bit_cast(s16x4,__builtin_amdgcn_ds_read_tr16_b64_v4i16((__attribute__((address_space(3))) v4i16_t*)p)); }
__device__ __forceinline__ float rowmax(const f32x16&p0,const f32x16&p1){
  float a=max3f(p0[0],p0[1],p1[0]),b=max3f(p0[2],p0[3],p1[1]);a=max3f(a,p1[2],p1[3]);
  #pragma unroll
  for(int r=4;r<16;r+=4){a=max3f(a,p0[r],p0[r+1]);b=max3f(b,p0[r+2],p0[r+3]);a=max3f(a,p1[r],p1[r+1]);b=max3f(b,p1[r+2],p1[r+3]);}
  const float m=max2f(a,b);
  auto rr=__builtin_amdgcn_permlane32_swap(__float_as_uint(m),__float_as_uint(m),false,false);
  return max2f(__uint_as_float(rr[0]),__uint_as_float(rr[1]));
}
__device__ __forceinline__ void pv(f32x16*o,int vb,bf16x8 pa0,bf16x8 pa1,bf16x8 pa2,bf16x8 pa3){
  #pragma unroll
  for(int d0=0;d0<2;++d0){s16x4 lo[4],hi[4];
    #pragma unroll
    for(int ks=0;ks<4;++ks){
      asm volatile("ds_read_b64_tr_b16 %0,%1 offset:%c2":"=&v"(lo[ks]):"v"(vb),"i"(d0*4096+ks*1024):"memory");
      asm volatile("ds_read_b64_tr_b16 %0,%1 offset:%c2":"=&v"(hi[ks]):"v"(vb),"i"(d0*4096+ks*1024+512):"memory");}
    asm volatile("s_waitcnt lgkmcnt(0)":::"memory");SBAR();
    #define PK(k) (bf16x8){lo[k][0],lo[k][1],lo[k][2],lo[k][3],hi[k][0],hi[k][1],hi[k][2],hi[k][3]}
    o[d0]=__builtin_amdgcn_mfma_f32_32x32x16_bf16(pa0,PK(0),o[d0],0,0,0);
    o[d0]=__builtin_amdgcn_mfma_f32_32x32x16_bf16(pa1,PK(1),o[d0],0,0,0);
    o[d0]=__builtin_amdgcn_mfma_f32_32x32x16_bf16(pa2,PK(2),o[d0],0,0,0);
    o[d0]=__builtin_amdgcn_mfma_f32_32x32x16_bf16(pa3,PK(3),o[d0],0,0,0);
    #undef PK
  }
}

#ifndef ATTN_STORE16
#define ATTN_STORE16(p,v) (*(u32x4*)(p)=(v))
#endif
template<int THRL> __device__ __forceinline__ void attn_unit(const bf16*Qu,const bf16*K0,const bf16*K1,int nt0,int NT,char*shm){
  int tid_=threadIdx.x; asm volatile("":"+v"(tid_));
  const int tid=tid_,lane=tid&63,r32=lane&31,hi=lane>>5; const int wid=__builtin_amdgcn_readfirstlane(tid>>6);
  const bf16*Qw=Qu+(long)(wid*QBLK)*DM;
  const unsigned lds0=(unsigned)(uintptr_t)shm;
  float*wsf=(float*)(shm+LDS_WS)+wid*64;
  const bf16*ksrc0=K0+(long)lane*DM+wid*8,*ksrc1=K1+(long)lane*DM+wid*8;
  const long voff_=(long)(16*(wid&3)+(lane>>2))*DM+(wid>>2)*32+(lane&3)*8+(C_V-C_K); const bf16*vsrc0=K0+voff_,*vsrc1=K1+voff_;
  const unsigned kdst=lds0+LDS_K+wid*1024, vdst=lds0+LDS_V+wid*1024;
  #define DMA_K(t,slot) glds16(((t)<nt0?ksrc0+(long)(t)*KVBLK*DM:ksrc1+(long)((t)-nt0)*KVBLK*DM),(unsigned)__builtin_amdgcn_readfirstlane(kdst+(slot)))
  #define DMA_V(t,slot) glds16(((t)<nt0?vsrc0+(long)(t)*KVBLK*DM:vsrc1+(long)((t)-nt0)*KVBLK*DM),(unsigned)__builtin_amdgcn_readfirstlane(vdst+(slot)))
  const int vb0=(int)(lds0+LDS_V)+((lane>>4)&1)*32+(lane&3)*8+(4*hi+((lane&15)>>2))*64;
  const char*Kbase=shm+LDS_K; bf16x8 kf[8];
  const lds_cptr shm3=(lds_cptr)shm; const lds_cptr kp0=shm3+LDS_K+hi*1024+r32*16; const lds_cptr vp0=shm3+LDS_V+((lane>>4)&1)*32+(lane&3)*8+(4*hi+((lane&15)>>2))*64;
  DMA_K(0,0);DMA_V(0,0);DMA_K(1,SLOTB);
  bf16x8 qr[4];
  #pragma unroll
  for(int d0=0;d0<4;++d0)qr[d0]=*reinterpret_cast<const bf16x8*>(&Qw[(long)r32*DM+d0*16+hi*8]);
  float mhat=0.f,l_reg=0.f;f32x16 o[2];o[0]=f32x16{};o[1]=f32x16{};f32x16 negm=f32x16{};asm volatile("":"+v"(negm));
  #define CMASK(P0,P1,t) do{}while(0)
  bool resc=false;
  #define START(P0,P1) do{ const float rm=rowmax(P0,P1); resc=false; \
    { const float dl=rm; mhat=fadd_s(mhat,dl); \
      _Pragma("unroll") for(int r=0;r<16;++r){P0[r]=fsub_s(P0[r],dl);P1[r]=fsub_s(P1[r],dl);} \
      _Pragma("unroll") for(int r=0;r<16;++r)negm[r]=-mhat; asm volatile("":"+v"(negm)); } \
    _Pragma("unroll") for(int r=0;r<16;++r)P0[r]=__builtin_amdgcn_exp2f(P0[r]); }while(0)
  #define RESC() do{ if(resc){ asm volatile("s_waitcnt lgkmcnt(0)":::"memory"); \
      _Pragma("unroll") for(int d_=0;d_<2;++d_) _Pragma("unroll") for(int r=0;r<16;++r)o[d_][r]*=wsf[crow(r,hi)]; } }while(0)
  f32x16 pA0,pA1,pB0,pB1;
  int sl_prev=0,sl_cur=0,sl_next=SLOTB;
  #define ROT() do{sl_prev=sl_cur;sl_cur=sl_next;sl_next=(sl_next==(NSLOT-1)*SLOTB)?0:sl_next+SLOTB;}while(0)
  DMA_K(2,2*SLOTB);
  WAIT_BAR(3);
  qkt(pA0,pA1,Kbase,qr,negm,r32,hi);asm volatile("s_nop 15\n\ts_nop 7":"+v"(pA0),"+v"(pA1));CMASK(pA0,pA1,0);
  START(pA0,pA1);
  _Pragma("unroll") for(int r=0;r<16;++r)pA1[r]=__builtin_amdgcn_exp2f(pA1[r]);
  WAIT_BAR(0);
  DMA_K(3,0);DMA_V(1,SLOTB);
  ROT();
  kload8(kf,kp0+sl_cur);
  WAIT_BAR(2);
  s16x4 vlo[8],vhi[8]; u32x4 pw0,pw1,pw2,pw3;
  #define PKW(P,B) cvtpk_s(P[B],P[B+1])
  #define PAF(k) __builtin_bit_cast(bf16x8,pw##k)
  #define VFR(i) (bf16x8){vlo[i][0],vlo[i][1],vlo[i][2],vlo[i][3],vhi[i][0],vhi[i][1],vhi[i][2],vhi[i][3]}
  #define PIN(x) asm volatile("":"+v"(x))
  #define MX3(a,b,c) __builtin_fmaxf(__builtin_fmaxf((a),(b)),(c))
  #define GAPA(MF,A0,A1,A2,A3,W0,W1,PW) do{ MF; sacc+=A0; sacc+=A1; sacc+=A2; sacc+=A3; PIN(sacc); W0; W1; PIN(PW); SBAR(); }while(0)
  #define EX(v) __builtin_amdgcn_exp2f(v)
  #define GAPB(MF,X,B) do{ MF; X[B]=EX(X[B]); X[B+1]=EX(X[B+1]); X[B+2]=EX(X[B+2]); X[B+3]=EX(X[B+3]); PIN(X); SBAR(); }while(0)
  #define VRD(i) do{ vlo[i]=vtr(vp_+(((i)>>2)*4096+((i)&3)*1024)); vhi[i]=vtr(vp_+(((i)>>2)*4096+((i)&3)*1024+512)); }while(0)
  #define KRD(G,j) do{ if(G){ kload2(kf,kp0+sl_next,j); SBAR(); } }while(0)
  #define STEP(C0,C1,P0,P1,t,GK,GV,GL) do{ SBAR(); \
    const lds_cptr vp_=vp0+sl_prev; \
    VRD(0); SBAR(); float sacc=(P0[0]+P0[1]); \
    GAPA(C0=__builtin_amdgcn_mfma_f32_32x32x16_bf16(kf[0],qr[0],negm,0,0,0), P0[2],P0[3],P0[4],P0[5],     pw0[0]=PKW(P0,0), pw0[1]=PKW(P0,2), pw0); \
    VRD(4); SBAR(); GAPA(C1=__builtin_amdgcn_mfma_f32_32x32x16_bf16(kf[1],qr[0],negm,0,0,0), P0[6],P0[7],P0[8],P0[9],     pw0[2]=PKW(P0,4), pw0[3]=PKW(P0,6), pw0); \
    VRD(1); SBAR(); GAPA(C0=__builtin_amdgcn_mfma_f32_32x32x16_bf16(kf[2],qr[1],C0,0,0,0),   P0[10],P0[11],P0[12],P0[13], pw1[0]=PKW(P0,8), pw1[1]=PKW(P0,10), pw1); \
    VRD(5); SBAR(); GAPA(C1=__builtin_amdgcn_mfma_f32_32x32x16_bf16(kf[3],qr[1],C1,0,0,0),   P0[14],P0[15],P1[0],P1[1],   pw1[2]=PKW(P0,12),pw1[3]=PKW(P0,14), pw1); \
    VRD(2); SBAR(); GAPA(C0=__builtin_amdgcn_mfma_f32_32x32x16_bf16(kf[4],qr[2],C0,0,0,0),   P1[2],P1[3],P1[4],P1[5],     pw2[0]=PKW(P1,0), pw2[1]=PKW(P1,2), pw2); \
    VRD(6); SBAR(); GAPA(C1=__builtin_amdgcn_mfma_f32_32x32x16_bf16(kf[5],qr[2],C1,0,0,0),   P1[6],P1[7],P1[8],P1[9],     pw2[2]=PKW(P1,4), pw2[3]=PKW(P1,6), pw2); \
    VRD(3); SBAR(); GAPA(C0=__builtin_amdgcn_mfma_f32_32x32x16_bf16(kf[6],qr[3],C0,0,0,0),   P1[10],P1[11],P1[12],P1[13], pw3[0]=PKW(P1,8), pw3[1]=PKW(P1,10), pw3); \
    VRD(7); SBAR(); GAPA(C1=__builtin_amdgcn_mfma_f32_32x32x16_bf16(kf[7],qr[3],C1,0,0,0),   P1[14],P1[15],0.f,0.f,       pw3[2]=PKW(P1,12),pw3[3]=PKW(P1,14), pw3); \
    l_reg+=sacc; \
    if(GK){DMA_K((t)+3,sl_cur);} if(GV){DMA_V((t)+1,sl_next);} \
    CMASK(C0,C1,t); \
    { float a=MX3(C0[0],C0[1],C1[0]),b=MX3(C0[2],C0[3],C1[1]); a=MX3(a,C1[2],C1[3]); \
      _Pragma("unroll") for(int r=4;r<16;r+=4){a=MX3(a,C0[r],C0[r+1]);b=MX3(b,C0[r+2],C0[r+3]);a=MX3(a,C1[r],C1[r+1]);b=MX3(b,C1[r+2],C1[r+3]);} \
      float rm=__builtin_fmaxf(a,b); { auto rr=__builtin_amdgcn_permlane32_swap(__float_as_uint(rm),__float_as_uint(rm),false,false); rm=__builtin_fmaxf(__uint_as_float(rr[0]),__uint_as_float(rr[1])); } \
      resc=false; \
      if(__builtin_expect(__any(rm>(float)THRL),0)){ const float dl=__builtin_fmaxf(rm,0.f); mhat+=dl; \
        _Pragma("unroll") for(int r=0;r<16;++r){C0[r]-=dl;C1[r]-=dl;} \
        _Pragma("unroll") for(int r=0;r<16;++r)negm[r]=-mhat; asm volatile("":"+v"(negm)); \
        const float f=__builtin_amdgcn_exp2f(-dl); l_reg*=f; if(hi==0)wsf[r32]=f; resc=true; } } \
    SBAR(); \
    GAPB(o[0]=__builtin_amdgcn_mfma_f32_32x32x16_bf16(PAF(0),VFR(0),o[0],0,0,0), C0,0); \
    GAPB(o[1]=__builtin_amdgcn_mfma_f32_32x32x16_bf16(PAF(0),VFR(4),o[1],0,0,0), C0,4); \
    KRD(GL,0); GAPB(o[0]=__builtin_amdgcn_mfma_f32_32x32x16_bf16(PAF(1),VFR(1),o[0],0,0,0), C0,8); \
    KRD(GL,1); GAPB(o[1]=__builtin_amdgcn_mfma_f32_32x32x16_bf16(PAF(1),VFR(5),o[1],0,0,0), C0,12); \
    KRD(GL,2); GAPB(o[0]=__builtin_amdgcn_mfma_f32_32x32x16_bf16(PAF(2),VFR(2),o[0],0,0,0), C1,0); \
    KRD(GL,3); GAPB(o[1]=__builtin_amdgcn_mfma_f32_32x32x16_bf16(PAF(2),VFR(6),o[1],0,0,0), C1,4); \
    GAPB(o[0]=__builtin_amdgcn_mfma_f32_32x32x16_bf16(PAF(3),VFR(3),o[0],0,0,0), C1,8); \
    GAPB(o[1]=__builtin_amdgcn_mfma_f32_32x32x16_bf16(PAF(3),VFR(7),o[1],0,0,0), C1,12); \
    }while(0)
  int t=1;
  #undef CMASK
  #define CMASK(P0,P1,t) do{}while(0)
  for(;t+5<NT;t+=2){
    STEP(pB0,pB1,pA0,pA1,t,true,true,true);     WAIT_BAR(2); RESC(); ROT();
    STEP(pA0,pA1,pB0,pB1,t+1,true,true,true);   WAIT_BAR(2); RESC(); ROT();
  }
  #undef CMASK
  #define CMASK(P0,P1,t) do{}while(0)
  #define ENDW(tt) do{ if((tt)+3<NT){WAIT_BAR(2);} else if((tt)+2<NT){WAIT_BAR(1);} else {WAIT_BAR(0);} }while(0)
  for(;t+1<NT;t+=2){
    STEP(pB0,pB1,pA0,pA1,t,(t+3<NT),(t+1<NT),(t+1<NT));       ENDW(t);   RESC(); ROT();
    STEP(pA0,pA1,pB0,pB1,t+1,(t+4<NT),(t+2<NT),(t+2<NT));     ENDW(t+1); RESC(); ROT();
  }
  STEP(pB0,pB1,pA0,pA1,NT-1,false,false,false); RESC();
  { float sacc=pB0[0]+pB0[1]; _Pragma("unroll") for(int r=2;r<16;++r)sacc+=pB0[r]; _Pragma("unroll") for(int r=0;r<16;++r)sacc+=pB1[r]; l_reg+=sacc;
    pw0=(u32x4){PKW(pB0,0),PKW(pB0,2),PKW(pB0,4),PKW(pB0,6)};pw1=(u32x4){PKW(pB0,8),PKW(pB0,10),PKW(pB0,12),PKW(pB0,14)};pw2=(u32x4){PKW(pB1,0),PKW(pB1,2),PKW(pB1,4),PKW(pB1,6)};pw3=(u32x4){PKW(pB1,8),PKW(pB1,10),PKW(pB1,12),PKW(pB1,14)};
    SBAR(); pv(o,vb0+sl_cur,PAF(0),PAF(1),PAF(2),PAF(3)); }
  #undef PKW
  #undef PAF
  #undef VFR
  #undef PIN
  #undef MX3
  #undef GAPA
  #undef GAPB
  #undef EX
  #undef VRD
  #undef KRD
  #undef STEP
  #undef ENDW
  {auto rr=__builtin_amdgcn_permlane32_swap(__float_as_uint(l_reg),__float_as_uint(l_reg),false,false);l_reg=__uint_as_float(rr[0])+__uint_as_float(rr[1]);}
  if(hi==0)wsf[32+r32]=l_reg;asm volatile("s_waitcnt lgkmcnt(0)":::"memory");
  float rli[16];
  #pragma unroll
  for(int r=0;r<16;++r)rli[r]=__builtin_amdgcn_rcpf(wsf[32+crow(r,hi)]);
  bf16*Ow=(bf16*)Qw; const bf16*Gw=Qw+(C_GB-C_Q);
  { bf16*stg=(bf16*)(shm+LDS_OST)+wid*2048;
    #pragma unroll
    for(int r=0;r<16;++r){const int orow=crow(r,hi);
      #pragma unroll
      for(int d0=0;d0<2;++d0)stg[orow*64+d0*32+r32]=__float2bfloat16(o[d0][r]*rli[r]);}
    asm volatile("s_waitcnt lgkmcnt(0)":::"memory");
    #pragma unroll
    for(int i=0;i<4;++i){const int row=i*8+(lane>>3),ch=lane&7; const u32x4 v=*(const u32x4*)(stg+row*64+ch*8); const u32x4 gt=*(const u32x4*)(Gw+(long)row*DM+ch*8); u32x4 w;
      #pragma unroll
      for(int q_=0;q_<4;++q_){ const float a0=__uint_as_float(v[q_]<<16)*__uint_as_float(gt[q_]<<16), a1=__uint_as_float(v[q_]&0xffff0000u)*__uint_as_float(gt[q_]&0xffff0000u); w[q_]=cvtpk_s(a0,a1); }
      ATTN_STORE16(Ow+(long)row*DM+ch*8,w);} }
  asm volatile("s_waitcnt lgkmcnt(0)\n\ts_barrier":::"memory");
  #undef DMA_K
  #undef DMA_V
  #undef CMASK
  #undef START
  #undef RESC
  #undef ROT
}
constexpr int ATTN_LDS_BYTES=LDS_BYTES;
#undef SBAR
#undef WAIT_BAR
}

constexpr int NWAVES = 8;
#ifndef MK_PER_PHASE
#define MK_PER_PHASE 0
#endif
constexpr size_t MiB = 1u << 20;
constexpr size_t WS_CTL = 0, CTL_ZERO_BYTES = 1 * MiB;
constexpr size_t WS_MODS = 1 * MiB, WS_ROPE = 2 * MiB, WS_AWS = 2 * MiB + 512 * 1024, WS_LRUW = 3 * MiB, WS_WIN = 4 * MiB, WS_WO = 24 * MiB, WS_XR = 34 * MiB,
                 WS_XM = 52 * MiB, WS_XT = 124 * MiB, WS_Z = 268 * MiB, WS_END = 484 * MiB;
static_assert(WS_WIN + (size_t)DEPTH * DIN * DMODEL * 2 <= WS_WO && WS_WO + (size_t)DEPTH * DMODEL * K2 * 2 <= WS_XR && WS_XR + (size_t)MROWS * 256 * 2 <= WS_XM &&
              WS_XM + (size_t)MROWS * DMODEL * 2 <= WS_XT && WS_XT + (size_t)MROWS * DMODEL * 4 <= WS_Z && WS_Z + (size_t)MROWS * ZP * 2 <= WS_END, "d_ws map");
constexpr int CW_BAR = 4096, CW_Q = 16384;
constexpr int RING_OFF = 0, RING_BYTES = 131072, LDSCTL_OFF = RING_BYTES, MISC_OFF = LDSCTL_OFF + 320, LDS_BYTES = 147456;
constexpr int NPHASE = 2 + 4 * DEPTH;

#define GAS __attribute__((address_space(1)))
#define LAS __attribute__((address_space(3)))
typedef unsigned short bf16;
typedef unsigned v4u __attribute__((ext_vector_type(4)));
typedef unsigned v2u __attribute__((ext_vector_type(2)));
typedef float f32x4 __attribute__((ext_vector_type(4)));
typedef float f32x16 __attribute__((ext_vector_type(16)));
typedef short bf16x8 __attribute__((ext_vector_type(8)));
typedef GAS unsigned gu32;
#define RLX_AGENT __ATOMIC_RELAXED, __HIP_MEMORY_SCOPE_AGENT
#define LDS_WAIT() asm volatile("s_waitcnt lgkmcnt(0)" ::: "memory")
#define VM_WAIT() asm volatile("s_waitcnt vmcnt(0)" ::: "memory")
__device__ __forceinline__ unsigned f2bf(float f) { unsigned u = __builtin_bit_cast(unsigned, f); return (u + 0x7fffu + ((u >> 16) & 1u)) >> 16; }
__device__ __forceinline__ unsigned pk2(float lo, float hi) { return f2bf(lo) | (f2bf(hi) << 16); }
__device__ __forceinline__ float bflo(unsigned w) { return __uint_as_float(w << 16); }
__device__ __forceinline__ float bfhi(unsigned w) { return __uint_as_float(w & 0xffff0000u); }
__device__ __forceinline__ float bf1(bf16 h) { return __uint_as_float((unsigned)h << 16); }
__device__ __forceinline__ int crow16(int r, int hi) { return (r & 3) + 8 * (r >> 2) + 4 * hi; }

#define XB_TMO      128
#define XB_XCNT(j)  (256  + 64 * (j))
#define XB_XSUB(j)  (1280 + 64 * (j))
#define XB_XGEN(j)  (2304 + 64 * (j))
#define XB_TOP      3328
#define XB_TOPGEN   3392
#define XCD_BAR_WORDS 3456
#define XB_SPIN_CAP (1u << 20)
__device__ __forceinline__ unsigned xb_ld(unsigned* p)              { return __hip_atomic_load(p, __ATOMIC_RELAXED, __HIP_MEMORY_SCOPE_AGENT); }
__device__ __forceinline__ unsigned xb_add(unsigned* p, unsigned v) { return __hip_atomic_fetch_add(p, v, __ATOMIC_RELAXED, __HIP_MEMORY_SCOPE_AGENT); }
__device__ __forceinline__ unsigned xb_xcc_id() { return (unsigned)__builtin_amdgcn_s_getreg((3 << 11) | 20) & 0xFu; }
#define XB_SPIN(cond, bar) do { unsigned _sp = 0; while (cond) { __builtin_amdgcn_s_sleep(1); \
    if ((++_sp & 255u) == 0u) { if (xb_ld(&(bar)[XB_TMO])) break; if (_sp > XB_SPIN_CAP) { atomicAdd(&(bar)[XB_TMO], 1u); break; } } } } while (0)
struct XcdBarrier { unsigned* bar; unsigned x; volatile LAS unsigned* st; };
__device__ __forceinline__ XcdBarrier xcd_barrier_post(unsigned* bar, volatile LAS unsigned* st) {
    XcdBarrier b; b.bar = bar; b.x = xb_xcc_id(); b.st = st;
    if (threadIdx.x == 0) (void)xb_add(&bar[XB_XCNT(b.x)], 1u);
    return b;
}
__device__ __forceinline__ void xcd_barrier_complete(unsigned* bar, unsigned x, unsigned& nloc, unsigned& nx) {
    const unsigned G = gridDim.x * gridDim.y * gridDim.z;
    unsigned sum, cnt, mine, sp = 0u;
    for (;;) {
        sum = 0u; cnt = 0u; mine = 0u;
#pragma unroll
        for (unsigned j = 0; j < 16; ++j) { const unsigned c = xb_ld(&bar[XB_XCNT(j)]); sum += c; cnt += (c > 0u) ? 1u : 0u; mine = (j == x) ? c : mine; }
        if (sum == G) break;
        __builtin_amdgcn_s_sleep(1);
        if ((++sp & 255u) == 0u) { if (xb_ld(&bar[XB_TMO])) break; if (sp > XB_SPIN_CAP) { atomicAdd(&bar[XB_TMO], 1u); break; } }
    }
    nloc = mine > 0u ? mine : 1u; nx = cnt > 0u ? cnt : 1u;
}
__device__ __forceinline__ void xcd_barrier(const XcdBarrier& b) {
    asm volatile("s_waitcnt vmcnt(0)" ::: "memory");
    __syncthreads();
    if (threadIdx.x == 0) {
        unsigned* bar = b.bar;
        __builtin_amdgcn_s_waitcnt(0);
        unsigned nloc = b.st[0], nx = b.st[1];
        if (nloc == 0u) { xcd_barrier_complete(bar, b.x, nloc, nx); b.st[0] = nloc; b.st[1] = nx; }
        const unsigned old = xb_add(&bar[XB_XSUB(b.x)], 1u);
        const unsigned gen = old / nloc;
        if (old + 1u == (gen + 1u) * nloc) {
            __builtin_amdgcn_fence(__ATOMIC_RELEASE, "agent");
            asm volatile("s_waitcnt vmcnt(0)" ::: "memory");
            const unsigned og = xb_add(&bar[XB_TOP], 1u);
            const unsigned tg = og / nx;
            if (og + 1u == (tg + 1u) * nx) xb_add(&bar[XB_TOPGEN], 1u);
            else XB_SPIN(xb_ld(&bar[XB_TOPGEN]) == tg, bar);
            __builtin_amdgcn_fence(__ATOMIC_ACQUIRE, "agent");
            xb_add(&bar[XB_XGEN(b.x)], 1u);
            asm volatile("s_waitcnt vmcnt(0)" ::: "memory");
        } else {
            XB_SPIN(xb_ld(&bar[XB_XGEN(b.x)]) == gen, bar);
            __builtin_amdgcn_fence(__ATOMIC_ACQUIRE, "agent");
            asm volatile("s_waitcnt vmcnt(0)" ::: "memory");
        }
    }
    __syncthreads();
}

__device__ __forceinline__ const float* inptr(int i) { const float* const* ka = (const float* const*)__builtin_amdgcn_kernarg_segment_ptr(); asm volatile("" : "+s"(i)); return ka[i]; }
struct Frame {
    LAS unsigned char* lds; unsigned char* ldsg;
    volatile LAS unsigned* MISC;
    gu32* ctl;
    int tid, lane, wave, bid, G;
    unsigned char* ws;
};

__device__ __forceinline__ float wave_sum(float v) {
#pragma unroll
    for (int o = 1; o < 64; o <<= 1) v += __shfl_xor(v, o);
    return v;
}

__device__ __forceinline__ void p0_transpose_item(const float* W, int ldsrc, int k0s, int c0s, bf16* WT, int ldd, int n0, int k0d, bool permq, LAS float* scr, int lane) {
    const int j = lane & 31; const int pos = permq ? (8 * ((j >> 2) & 3) + 4 * (j >> 4) + (j & 3)) : j;
#pragma unroll 8
    for (int i = 0; i < 32; ++i) { const int kk = 2 * i + (lane >> 5); scr[kk * 33 + pos] = W[(size_t)(k0s + kk) * ldsrc + c0s + j]; }
    LDS_WAIT(); asm volatile("" ::: "memory");
    const int c = lane & 7;
#pragma unroll
    for (int jj = 0; jj < 4; ++jj) { const int n = (lane >> 3) + 8 * jj; const LAS float* s = scr + (8 * c) * 33 + n;
        v4u o; o.x = pk2(s[0 * 33], s[1 * 33]); o.y = pk2(s[2 * 33], s[3 * 33]); o.z = pk2(s[4 * 33], s[5 * 33]); o.w = pk2(s[6 * 33], s[7 * 33]);
        *(GAS v4u*)(WT + (size_t)(n0 + n) * ldd + k0d + 8 * c) = o; }
    LDS_WAIT(); asm volatile("" ::: "memory");
}
__device__ __forceinline__ void p0a(Frame& F) {
    bf16* const AWS_ = (bf16*)(F.ws + WS_AWS); bf16* const LRUW_ = (bf16*)(F.ws + WS_LRUW); bf16* const WIN_ = (bf16*)(F.ws + WS_WIN); bf16* const WO_ = (bf16*)(F.ws + WS_WO); const float* const a_ws_ = inptr(9); const float* const b_ada_ = inptr(5); const float* const c_ = inptr(1); const float* const cctx_ = inptr(3); const float* const lru_wi_ = inptr(17); const float* const lru_wr_ = inptr(15); float* const mods_ = (float*)(F.ws + WS_MODS); float* const rope_ = (float*)(F.ws + WS_ROPE); const float* const w_ada_ = inptr(4); const float* const w_in_ = inptr(6); const float* const w_o_ = inptr(20);
    int tid_ = threadIdx.x; asm volatile("" : "+v"(tid_)); const int tid = tid_, lane = tid & 63, wave = __builtin_amdgcn_readfirstlane(tid >> 6); (void)tid; (void)lane; (void)wave;
    {
        LAS float* sS = (LAS float*)F.lds; LAS float* red = (LAS float*)(F.lds + 17 * 1024 * 4);
        bool filled = false;
        for (int it = F.bid; it < DEPTH * 48; it += F.G) {
            const int l = it / 48, cb = it % 48;
            if (!filled) { for (int idx = tid; idx < 17 * 1024; idx += 512) { const int r = idx >> 10, k = idx & 1023; const float cv = r < 16 ? c_[r * 1024 + k] : cctx_[k]; sS[idx] = cv / (1.f + expf(-cv)); } filled = true; }
            __syncthreads();
            float acc[17];
#pragma unroll
            for (int r = 0; r < 17; ++r) acc[r] = 0.f;
            const float* wp = w_ada_ + ((size_t)l * 1024 + 128 * wave) * 3072 + 64 * cb + lane;
#pragma unroll 4
            for (int k = 0; k < 128; ++k) { const float wv = wp[(size_t)k * 3072];
#pragma unroll
                for (int r = 0; r < 17; ++r) acc[r] += sS[r * 1024 + 128 * wave + k] * wv; }
#pragma unroll
            for (int r = 0; r < 17; ++r) red[(wave * 17 + r) * 64 + lane] = acc[r];
            __syncthreads();
            for (int idx = tid; idx < 17 * 64; idx += 512) { const int r = idx >> 6, ln = idx & 63; float s = b_ada_[l * 3072 + 64 * cb + ln];
#pragma unroll
                for (int w = 0; w < 8; ++w) s += red[(w * 17 + r) * 64 + ln];
                mods_[((size_t)l * 17 + r) * 3072 + 64 * cb + ln] = s; }
            __syncthreads();
        }
    }
    if (F.bid == F.G - 1) {
        for (int idx = tid; idx < 1024; idx += 512) { const int pos = idx >> 4, i = idx & 15;
            const float inv = exp2f(-(float)i * (13.287712379549449f / 16.f)); const float ang = (float)pos * inv;
            const float kq = rintf(ang * 0.15915494309189535f); float rr = fmaf(-kq, 6.2831854820251465f, ang); rr = fmaf(-kq, -1.7484556e-7f, rr);
            rope_[idx] = __cosf(rr); rope_[1024 + idx] = __sinf(rr); }
    }
    __syncthreads();
    {
        LAS float* scr = (LAS float*)(F.lds + wave * 16384);
        const int gw = F.bid * NWAVES + wave, NGW = F.G * NWAVES;
        constexpr int I_IN = 16 * 80, I_O = 20 * 32;
        for (int it = gw; it < DEPTH * (I_IN + I_O); it += NGW) {
            const int l = it / (I_IN + I_O); int r = it % (I_IN + I_O);
            if (r < I_IN) {
                const int kb = r / 80, grp = r % 80;
                const int pn = grp >> 3, bj = (grp >> 2) & 1, wc = grp & 3;
                int lbase; bool pq = false;
                if (pn == 3 || pn == 4) { lbase = 768 + 64 * (wc + 4 * (pn - 3)) + 32 * bj; pq = true; }
                else if (pn == 5) { if (wc < 2) { lbase = 1280 + 64 * wc + 32 * bj; pq = true; } else lbase = 1408 + 64 * (wc - 2) + 32 * bj; }
                else { const int lb[10] = {0, 256, 512, 0, 0, 0, 1536, 1792, 2048, 2304}; lbase = lb[pn] + 128 * bj + 32 * wc; }
                p0_transpose_item(w_in_ + (size_t)l * DMODEL * DIN, DIN, 64 * kb, lbase, WIN_ + (size_t)l * DIN * DMODEL, DMODEL, 32 * grp, 64 * kb, pq, scr, lane);
            } else {
                r -= I_IN; const int kb = r / 32, nb = r % 32; const int k0d = 64 * kb, k0s = k0d < 1024 ? k0d : k0d - 256;
                p0_transpose_item(w_o_ + (size_t)l * DMODEL * DMODEL, DMODEL, k0s, 32 * nb, WO_ + (size_t)l * DMODEL * K2, K2, 32 * nb, k0d, false, scr, lane);
            }
        }
    }
    {
        const int gt = F.bid * 512 + tid, NT_ = F.G * 512;
        for (int i = gt; i < DEPTH * 4 * 128 * 128 / 4; i += NT_) { const f32x4 v = *(const f32x4*)(a_ws_ + (size_t)i * 4); v2u o; o.x = pk2(v[0], v[1]); o.y = pk2(v[2], v[3]); *(v2u*)(AWS_ + (size_t)i * 4) = o; }
        for (int i = gt; i < DEPTH * 2 * 4 * 2 * 2 * 4 * 64; i += NT_) {
            const int ln = i & 63, s = (i >> 6) & 3, nt = (i >> 8) & 1, g = (i >> 9) & 1, j = (i >> 10) & 3, d = (i >> 12) & 1, l = i >> 13;
            const float* w = (g == 0 ? lru_wr_ : lru_wi_) + ((size_t)((l * 2 + d) * 4 + j) * 64) * 64;
            const int col = 32 * nt + (ln & 31), i0 = 16 * s + 8 * (ln >> 5);
            v4u o; o.x = pk2(w[(i0 + 0) * 64 + col], w[(i0 + 1) * 64 + col]); o.y = pk2(w[(i0 + 2) * 64 + col], w[(i0 + 3) * 64 + col]);
            o.z = pk2(w[(i0 + 4) * 64 + col], w[(i0 + 5) * 64 + col]); o.w = pk2(w[(i0 + 6) * 64 + col], w[(i0 + 7) * 64 + col]);
            *(v4u*)(LRUW_ + (size_t)i * 8) = o; }
    }
}
__device__ __forceinline__ void p0b(Frame& F) {
    bf16* const XM_ = (bf16*)(F.ws + WS_XM); const float* const ctx_ = inptr(2); float* const mods_ = (float*)(F.ws + WS_MODS); const float* const x_ = inptr(0);
    int tid_ = threadIdx.x; asm volatile("" : "+v"(tid_)); const int tid = tid_, lane = tid & 63, wave = __builtin_amdgcn_readfirstlane(tid >> 6); (void)tid; (void)lane; (void)wave;
    const int gw = F.bid * NWAVES + wave, NGW = F.G * NWAVES;
    for (int m = gw; m < MROWS; m += NGW) {
        const float* src = m < NLAT ? x_ + (size_t)m * DMODEL : ctx_ + (size_t)(m - NLAT) * DMODEL; const int mrow = m < NLAT ? (m >> 11) : 16;
        const float* md = mods_ + (size_t)mrow * 3072;
        GAS v2u* o8 = (GAS v2u*)(XM_ + (size_t)m * DMODEL) + lane;
#pragma unroll
        for (int j = 0; j < 4; ++j) { const int k = 4 * lane + 256 * j; const f32x4 v = *(const f32x4*)(src + k), sh = *(const f32x4*)(md + k), sc = *(const f32x4*)(md + 1024 + k);
            const f32x4 o = v * (sc + 1.0f) + sh; v2u w; w.x = pk2(o[0], o[1]); w.y = pk2(o[2], o[3]); o8[64 * j] = w; }
    }
}
__device__ __forceinline__ void p4_ln(Frame& F, int l) {
    int tid_ = threadIdx.x; asm volatile("" : "+v"(tid_)); const int tid = tid_, lane = tid & 63, wave = __builtin_amdgcn_readfirstlane(tid >> 6); (void)tid;
    const float* const ln_g_ = inptr(21); const float* const ln_b_ = inptr(22); float* const out_ = (float*)inptr(23);
    float* const XT_ = (float*)(F.ws + WS_XT); bf16* const XM_ = (bf16*)(F.ws + WS_XM); const float* const mods_ = (const float*)(F.ws + WS_MODS);
    const int gw = F.bid * NWAVES + wave, NGW = F.G * NWAVES; const bool last = (l == DEPTH - 1); const int mend = last ? NLAT : MROWS;
    const float* lg = ln_g_ + l * DMODEL + 4 * lane; const float* lb = ln_b_ + l * DMODEL + 4 * lane;
    for (int m0 = gw; m0 < mend; m0 += 2 * NGW) {
        const int m1 = m0 + NGW; const bool has1 = m1 < mend; const int m1c = has1 ? m1 : m0;
        float* row0 = XT_ + (size_t)m0 * DMODEL + 4 * lane; float* row1 = XT_ + (size_t)m1c * DMODEL + 4 * lane;
        f32x4 v0[4], v1[4]; float s0 = 0.f, s1 = 0.f;
#pragma unroll
        for (int j = 0; j < 4; ++j) { v0[j] = *(const f32x4*)(row0 + 256 * j); v1[j] = *(const f32x4*)(row1 + 256 * j); }
#pragma unroll
        for (int j = 0; j < 4; ++j) { s0 += (v0[j][0] + v0[j][1]) + (v0[j][2] + v0[j][3]); s1 += (v1[j][0] + v1[j][1]) + (v1[j][2] + v1[j][3]); }
#pragma unroll
        for (int o = 1; o < 64; o <<= 1) { s0 += __shfl_xor(s0, o); s1 += __shfl_xor(s1, o); }
        const float mean0 = s0 * (1.f / DMODEL), mean1 = s1 * (1.f / DMODEL); float q0 = 0.f, q1 = 0.f;
#pragma unroll
        for (int j = 0; j < 4; ++j) { v0[j] = v0[j] - mean0; v1[j] = v1[j] - mean1; q0 += (v0[j][0] * v0[j][0] + v0[j][1] * v0[j][1]) + (v0[j][2] * v0[j][2] + v0[j][3] * v0[j][3]); q1 += (v1[j][0] * v1[j][0] + v1[j][1] * v1[j][1]) + (v1[j][2] * v1[j][2] + v1[j][3] * v1[j][3]); }
#pragma unroll
        for (int o = 1; o < 64; o <<= 1) { q0 += __shfl_xor(q0, o); q1 += __shfl_xor(q1, o); }
        const float rstd0 = 1.f / sqrtf(q0 * (1.f / DMODEL) + 1e-6f), rstd1 = 1.f / sqrtf(q1 * (1.f / DMODEL) + 1e-6f);
#pragma unroll
        for (int rr = 0; rr < 2; ++rr) { if (rr == 1 && !has1) break;
            const int m = rr ? m1 : m0; const float rstd = rr ? rstd1 : rstd0; float* row = rr ? row1 : row0;
            const int mrow = m < NLAT ? (m >> 11) : 16; const float* md = mods_ + ((size_t)(l + 1) * 17 + mrow) * 3072 + 4 * lane;
            GAS v2u* o8 = (GAS v2u*)(XM_ + (size_t)m * DMODEL) + lane;
#pragma unroll
            for (int j = 0; j < 4; ++j) { const f32x4 vv = rr ? v1[j] : v0[j]; const f32x4 o = vv * rstd * *(const f32x4*)(lg + 256 * j) + *(const f32x4*)(lb + 256 * j);
                if (last) { *(f32x4*)(out_ + (size_t)m * DMODEL + 4 * lane + 256 * j) = o; }
                else { *(f32x4*)(row + 256 * j) = o; const f32x4 sh = *(const f32x4*)(md + 256 * j), sc = *(const f32x4*)(md + 1024 + 256 * j); const f32x4 xm = o * (sc + 1.0f) + sh;
                    v2u w; w.x = pk2(xm[0], xm[1]); w.y = pk2(xm[2], xm[3]); o8[64 * j] = w; } }
        }
    }
}
__device__ __forceinline__ void gmlp_unit(Frame& F, int l, int chunk) {
    bf16* const AWS_ = (bf16*)(F.ws + WS_AWS); bf16* const Z_ = (bf16*)(F.ws + WS_Z); const float* const a_bs_ = inptr(10); const float* const a_norm_b_ = inptr(8); const float* const a_norm_g_ = inptr(7);
    int tid_ = threadIdx.x; asm volatile("" : "+v"(tid_)); const int tid = tid_, lane = tid & 63, wave = __builtin_amdgcn_readfirstlane(tid >> 6); (void)tid; (void)lane; (void)wave; const int R0 = chunk * 128;
    constexpr int VP = 136;
    LAS bf16* VnT = (LAS bf16*)F.lds;
    {
        const int l5 = lane & 31, half = lane >> 5; const float* ng = a_norm_g_ + l * 256 + 8 * l5; const float* nb = a_norm_b_ + l * 256 + 8 * l5;
        const f32x4 g0 = *(const f32x4*)ng, g1 = *(const f32x4*)(ng + 4), b0 = *(const f32x4*)nb, b1 = *(const f32x4*)(nb + 4);
#pragma unroll 2
        for (int i = 0; i < 8; ++i) { const int tok = 16 * wave + 2 * i + half;
            const v4u raw = *(const v4u*)(Z_ + (size_t)(R0 + tok) * ZP + C_VA + 8 * l5);
            float v[8]; v[0] = bflo(raw.x); v[1] = bfhi(raw.x); v[2] = bflo(raw.y); v[3] = bfhi(raw.y); v[4] = bflo(raw.z); v[5] = bfhi(raw.z); v[6] = bflo(raw.w); v[7] = bfhi(raw.w);
            float s = ((v[0] + v[1]) + (v[2] + v[3])) + ((v[4] + v[5]) + (v[6] + v[7]));
#pragma unroll
            for (int o = 1; o < 32; o <<= 1) s += __shfl_xor(s, o);
            const float mu = s * (1.f / 256.f); float q = 0.f;
#pragma unroll
            for (int c = 0; c < 8; ++c) { v[c] -= mu; q += v[c] * v[c]; }
#pragma unroll
            for (int o = 1; o < 32; o <<= 1) q += __shfl_xor(q, o);
            const float rstd = 1.f / sqrtf(q * (1.f / 256.f) + 1e-6f);
#pragma unroll
            for (int c = 0; c < 8; ++c) { const float gg = c < 4 ? g0[c & 3] : g1[c & 3], bb = c < 4 ? b0[c & 3] : b1[c & 3]; VnT[(8 * l5 + c) * VP + tok] = (bf16)f2bf(v[c] * rstd * gg + bb); }
        }
    }
    __syncthreads();
    const int g = wave >> 1, ph = wave & 1, r32 = lane & 31, hi = lane >> 5;
    f32x16 acc[2][2];
#pragma unroll
    for (int a = 0; a < 2; ++a)
#pragma unroll
        for (int b = 0; b < 2; ++b)
#pragma unroll
            for (int e = 0; e < 16; ++e) acc[a][b][e] = 0.f;
    {
        const bf16* A0 = AWS_ + ((size_t)(l * 4 + g) * 128 + 64 * ph + r32) * 128 + 8 * hi;
        const LAS bf16* B0 = VnT + (64 * g + r32) * VP + 8 * hi;
#pragma unroll
        for (int s = 0; s < 8; ++s) {
            bf16x8 a[2], b[2];
#pragma unroll
            for (int mt = 0; mt < 2; ++mt) a[mt] = *(const bf16x8*)(A0 + mt * 32 * 128 + 16 * s);
#pragma unroll
            for (int nt = 0; nt < 2; ++nt) b[nt] = *(const LAS bf16x8*)(B0 + nt * 32 * VP + 16 * s);
#pragma unroll
            for (int mt = 0; mt < 2; ++mt)
#pragma unroll
                for (int nt = 0; nt < 2; ++nt) acc[mt][nt] = __builtin_amdgcn_mfma_f32_32x32x16_bf16(a[mt], b[nt], acc[mt][nt], 0, 0, 0);
        }
    }
    const float* bs = a_bs_ + (l * 4 + g) * 128;
#pragma unroll
    for (int mt = 0; mt < 2; ++mt)
#pragma unroll
        for (int reg = 0; reg < 16; ++reg) { const int p = 64 * ph + 32 * mt + crow16(reg, hi); const float bsv = bs[p]; bf16* zp = Z_ + (size_t)(R0 + p) * ZP + 64 * g + r32;
#pragma unroll
            for (int nt = 0; nt < 2; ++nt) { const float u = bf1(zp[C_MA + 32 * nt]), ga = bf1(zp[C_GA + 32 * nt]); zp[C_MA + 32 * nt] = (bf16)f2bf(u * (acc[mt][nt][reg] + bsv) * ga); } }
}
__device__ __forceinline__ void lru_conv_out(const v4u& r0, const v4u& r1, const v4u& r2, const v4u& r3, const f32x4 (&w0)[4], const f32x4 (&w1)[4], const f32x4& cb0, const f32x4& cb1, bf16* dst) {
    f32x4 y0 = cb0, y1 = cb1;
    y0 += w0[0] * (f32x4){bflo(r0.x), bfhi(r0.x), bflo(r0.y), bfhi(r0.y)}; y1 += w1[0] * (f32x4){bflo(r0.z), bfhi(r0.z), bflo(r0.w), bfhi(r0.w)};
    y0 += w0[1] * (f32x4){bflo(r1.x), bfhi(r1.x), bflo(r1.y), bfhi(r1.y)}; y1 += w1[1] * (f32x4){bflo(r1.z), bfhi(r1.z), bflo(r1.w), bfhi(r1.w)};
    y0 += w0[2] * (f32x4){bflo(r2.x), bfhi(r2.x), bflo(r2.y), bfhi(r2.y)}; y1 += w1[2] * (f32x4){bflo(r2.z), bfhi(r2.z), bflo(r2.w), bfhi(r2.w)};
    y0 += w0[3] * (f32x4){bflo(r3.x), bfhi(r3.x), bflo(r3.y), bfhi(r3.y)}; y1 += w1[3] * (f32x4){bflo(r3.z), bfhi(r3.z), bflo(r3.w), bfhi(r3.w)};
    v4u o; o.x = pk2(y0[0], y0[1]); o.y = pk2(y0[2], y0[3]); o.z = pk2(y1[0], y1[1]); o.w = pk2(y1[2], y1[3]);
    *(v4u*)dst = o;
}
__device__ __forceinline__ void lru_unit(Frame& F, int l, int b, int j) {
    int tid_ = threadIdx.x; asm volatile("" : "+v"(tid_)); const int tid = tid_, lane = tid & 63, wave = __builtin_amdgcn_readfirstlane(tid >> 6);
    bf16* const Z_ = (bf16*)(F.ws + WS_Z); bf16* const XR_ = (bf16*)(F.ws + WS_XR);
    {
        const float* const conv_w_ = inptr(13); const float* const conv_b_ = inptr(14);
        const int c8 = tid & 7, tg = tid >> 3; const int ch = 64 * j + 8 * c8;
        f32x4 w0[4], w1[4];
#pragma unroll
        for (int tap = 0; tap < 4; ++tap) { w0[tap] = *(const f32x4*)(conv_w_ + (l * 4 + tap) * 256 + ch); w1[tap] = *(const f32x4*)(conv_w_ + (l * 4 + tap) * 256 + ch + 4); }
        const f32x4 cb0 = *(const f32x4*)(conv_b_ + l * 256 + ch), cb1 = *(const f32x4*)(conv_b_ + l * 256 + ch + 4);
        const v4u zero = {0u, 0u, 0u, 0u};
#pragma unroll 1
        for (int seg = 0; seg < 2; ++seg) { const int rowbase = seg ? b * SEQ : NLAT + b * CTXL, L = seg ? SEQ : CTXL, per = L >> 6; const int ta = tg * per;
            const bf16* zp = Z_ + (size_t)rowbase * ZP + C_RX + ch; bf16* xp = XR_ + (size_t)rowbase * 256 + ch;
            v4u rm2 = ta >= 2 ? *(const v4u*)(zp + (size_t)(ta - 2) * ZP) : zero, rm1 = ta >= 1 ? *(const v4u*)(zp + (size_t)(ta - 1) * ZP) : zero, r0 = *(const v4u*)(zp + (size_t)ta * ZP);
#pragma unroll 1
            for (int t = ta; t < ta + per; t += 4) {
                const v4u n0 = (t + 1 < L) ? *(const v4u*)(zp + (size_t)(t + 1) * ZP) : zero, n1 = (t + 2 < L) ? *(const v4u*)(zp + (size_t)(t + 2) * ZP) : zero,
                          n2 = (t + 3 < L) ? *(const v4u*)(zp + (size_t)(t + 3) * ZP) : zero, n3 = (t + 4 < L) ? *(const v4u*)(zp + (size_t)(t + 4) * ZP) : zero;
                lru_conv_out(rm2, rm1, r0, n0, w0, w1, cb0, cb1, xp + (size_t)t * 256);
                lru_conv_out(rm1, r0, n0, n1, w0, w1, cb0, cb1, xp + (size_t)(t + 1) * 256);
                lru_conv_out(r0, n0, n1, n2, w0, w1, cb0, cb1, xp + (size_t)(t + 2) * 256);
                lru_conv_out(n0, n1, n2, n3, w0, w1, cb0, cb1, xp + (size_t)(t + 3) * 256);
                rm2 = n1; rm1 = n2; r0 = n3; } }
    }
    VM_WAIT(); __syncthreads();
    if (wave >= 4) return;
    const bf16* const LRUW_ = (const bf16*)(F.ws + WS_LRUW);
    const int d = __builtin_amdgcn_readfirstlane(wave >> 1), nt = __builtin_amdgcn_readfirstlane(wave & 1);
    const int r32 = lane & 31, hi = lane >> 5; const int c = 64 * j + 32 * nt + r32;
    bf16x8 Wr[4], Wi[4], Id[4];
    { const bf16* lw = LRUW_ + ((size_t)((((l * 2 + d) * 4 + j) * 2 + 0) * 2 + nt) * 4) * 64 * 8;
#pragma unroll
      for (int s = 0; s < 4; ++s) { Wr[s] = *(const bf16x8*)(lw + (s * 64 + lane) * 8); Wi[s] = *(const bf16x8*)(lw + 2 * 4 * 64 * 8 + (s * 64 + lane) * 8);
#pragma unroll
          for (int e = 0; e < 8; ++e) Id[s][e] = (16 * s + 8 * hi + e == 32 * nt + r32) ? (short)0x3F80 : (short)0; } }
    const float brv = inptr(16)[(l * 2 + d) * 256 + c], biv = inptr(18)[(l * 2 + d) * 256 + c];
    const float lam = inptr(19)[(l * 2 + d) * 256 + c]; const float ka = 8.0f * 1.4426950408889634f * log1pf(expf(-lam));
    const int ocol = (d ? C_HB : C_HF) + c;
    constexpr int NTC = CTXL / 32, NTL = SEQ / 32, NTT = NTC + NTL;
#define LRU_ROW0(ti) ((ti) < NTC ? NLAT + b * CTXL + 32 * (d ? NTC - 1 - (ti) : (ti)) : b * SEQ + 32 * (d ? NTL - 1 - ((ti) - NTC) : (ti) - NTC))
    bf16x8 An[4]; bf16 gn[16];
    { const int row0 = LRU_ROW0(0); const bf16* ap = XR_ + (size_t)(row0 + r32) * 256 + 64 * j + 8 * hi;
#pragma unroll
      for (int s = 0; s < 4; ++s) An[s] = *(const bf16x8*)(ap + 16 * s);
      const bf16* gp = Z_ + (size_t)(row0 + 4 * hi) * ZP + C_RG + c;
#pragma unroll
      for (int e = 0; e < 16; ++e) gn[e] = gp[(size_t)((e & 3) + 8 * (e >> 2)) * ZP]; }
    float carry = 0.f;
#pragma unroll 1
    for (int ti = 0; ti < NTT; ++ti) {
        const int row0 = LRU_ROW0(ti);
        bf16x8 A[4]; bf16 gt[16];
#pragma unroll
        for (int s = 0; s < 4; ++s) A[s] = An[s];
#pragma unroll
        for (int e = 0; e < 16; ++e) gt[e] = gn[e];
        { const int tn = ti + 1 < NTT ? ti + 1 : ti; const int rown = LRU_ROW0(tn); const bf16* ap = XR_ + (size_t)(rown + r32) * 256 + 64 * j + 8 * hi;
#pragma unroll
          for (int s = 0; s < 4; ++s) An[s] = *(const bf16x8*)(ap + 16 * s);
          const bf16* gp = Z_ + (size_t)(rown + 4 * hi) * ZP + C_RG + c;
#pragma unroll
          for (int e = 0; e < 16; ++e) gn[e] = gp[(size_t)((e & 3) + 8 * (e >> 2)) * ZP]; }
        f32x16 ar, ai, ax;
#pragma unroll
        for (int e = 0; e < 16; ++e) { ar[e] = 0.f; ai[e] = 0.f; ax[e] = 0.f; }
#pragma unroll
        for (int s = 0; s < 4; ++s) { ar = __builtin_amdgcn_mfma_f32_32x32x16_bf16(A[s], Wr[s], ar, 0, 0, 0); ai = __builtin_amdgcn_mfma_f32_32x32x16_bf16(A[s], Wi[s], ai, 0, 0, 0);
            ax = __builtin_amdgcn_mfma_f32_32x32x16_bf16(A[s], Id[s], ax, 0, 0, 0); }
        float av[16], bx[16];
#pragma unroll
        for (int e = 0; e < 16; ++e) { const float rr = __builtin_amdgcn_rcpf(1.f + __builtin_amdgcn_exp2f(-1.4426950408889634f * (ar[e] + brv)));
            const float ii = __builtin_amdgcn_rcpf(1.f + __builtin_amdgcn_exp2f(-1.4426950408889634f * (ai[e] + biv)));
            const float a = __builtin_amdgcn_exp2f(-ka * rr); av[e] = a; bx[e] = __builtin_amdgcn_sqrtf(fmaxf(1.f - a * a, 0.f)) * ii * ax[e]; }
        float hl[16], pl[16], Pk[4], Sk[4];
        if (d == 0) {
#pragma unroll
            for (int k = 0; k < 4; ++k) { float S = 0.f, P = 1.f;
#pragma unroll
                for (int e = 0; e < 4; ++e) { const int i = 4 * k + e; S = av[i] * S + bx[i]; P *= av[i]; hl[i] = S; pl[i] = P; } Pk[k] = P; Sk[k] = S; }
        } else {
#pragma unroll
            for (int k = 0; k < 4; ++k) { float S = 0.f, P = 1.f;
#pragma unroll
                for (int e = 3; e >= 0; --e) { const int i = 4 * k + e; S = av[i] * S + bx[i]; P *= av[i]; hl[i] = S; pl[i] = P; } Pk[k] = P; Sk[k] = S; }
        }
        float cin[4]; float cc = carry;
        if (d == 0) {
#pragma unroll
            for (int k = 0; k < 4; ++k) { const float Pp = __shfl_xor(Pk[k], 32), Sp = __shfl_xor(Sk[k], 32);
                const float P0 = hi ? Pp : Pk[k], S0 = hi ? Sp : Sk[k], P1 = hi ? Pk[k] : Pp, S1 = hi ? Sk[k] : Sp;
                const float c0 = cc; cc = P0 * cc + S0; const float c1 = cc; cc = P1 * cc + S1; cin[k] = hi ? c1 : c0; }
        } else {
#pragma unroll
            for (int k = 3; k >= 0; --k) { const float Pp = __shfl_xor(Pk[k], 32), Sp = __shfl_xor(Sk[k], 32);
                const float P0 = hi ? Pp : Pk[k], S0 = hi ? Sp : Sk[k], P1 = hi ? Pk[k] : Pp, S1 = hi ? Sk[k] : Sp;
                const float c1 = cc; cc = P1 * cc + S1; const float c0 = cc; cc = P0 * cc + S0; cin[k] = hi ? c1 : c0; }
        }
        carry = cc;
        bf16* zp = Z_ + (size_t)(row0 + 4 * hi) * ZP + ocol;
#pragma unroll
        for (int e = 0; e < 16; ++e) { const float h = hl[e] + pl[e] * cin[e >> 2]; zp[(size_t)((e & 3) + 8 * (e >> 2)) * ZP] = (bf16)f2bf(h * bf1(gt[e])); }
    }
#undef LRU_ROW0
}

struct Args { const float* in[23]; float* out; unsigned char* ws; int ph_lo, ph_hi; };
__global__ void __launch_bounds__(NWAVES * 64, 2) mk_fwd(Args args) {
    extern __shared__ __attribute__((aligned(16))) unsigned char lds[];
    Frame F;
    F.lds = (LAS unsigned char*)lds; F.ldsg = lds;
    F.MISC = (volatile LAS unsigned*)(F.lds + MISC_OFF);
    F.tid = threadIdx.x; F.lane = F.tid & 63; F.wave = __builtin_amdgcn_readfirstlane(F.tid >> 6);
    F.G = gridDim.x; F.bid = blockIdx.x;
    unsigned char* ws = args.ws;
    F.ws = ws; F.ctl = (gu32*)(ws + WS_CTL);
    for (int u = F.tid; u < (LDS_BYTES - LDSCTL_OFF) / 4; u += NWAVES * 64) ((LAS unsigned*)(F.lds + LDSCTL_OFF))[u] = 0u;
    __syncthreads();
    XcdBarrier bar; bar.bar = (unsigned*)(F.ctl + CW_BAR); bar.x = 0; bar.st = nullptr;
    const int lo = args.ph_lo, hi = args.ph_hi;
    if (hi - lo > 1) bar = xcd_barrier_post((unsigned*)(F.ctl + CW_BAR), F.MISC + 8);
#ifndef PROBE_MASK
#define PROBE_MASK 0u
#endif
#ifndef PROBE_MULT
#define PROBE_MULT 8
#endif
    unsigned long long t_prev = 0ull, t_acc = 0ull, t_unit = 0ull; (void)t_unit;
    if (PROBE_MASK != 0u) t_prev = __builtin_amdgcn_s_memrealtime();
#define STAMP(k) do { if (PROBE_MASK != 0u) { const unsigned long long t_now = __builtin_amdgcn_s_memrealtime(); if ((PROBE_MASK >> (k)) & 1u) t_acc += t_now - t_prev; t_prev = t_now; } } while (0)
#define IN(k) (lo <= (k) && (k) < hi)
#define SEAM(k) do { if (IN(k) && IN((k) + 1)) xcd_barrier(bar); } while (0)

    if (IN(0)) { p0a(F); SEAM(0); STAMP(0); }
    if (IN(1)) { p0b(F); SEAM(1); STAMP(1); }
#pragma unroll 1
    for (int l = 0; l < DEPTH; ++l) {
        const int pb = 2 + 4 * l; const bool last = (l == DEPTH - 1);
        if (IN(pb)) {
            pg8::Gemm g{(const bf16*)(ws + WS_XM), (const bf16*)(ws + WS_WIN) + (size_t)l * DIN * DMODEL, MROWS, DIN, DMODEL, DMODEL}; pg8::StaticOrder S; S.init(MROWS, DIN, F.G, F.bid);
            pg8::Epi1 E{(bf16*)(ws + WS_Z), inptr(11) + l * 64, inptr(12) + l * 64, (const float*)(ws + WS_ROPE)};
            pg8::gemm_phase<pg8::Epi1, pg8::StaticOrder, true, true>(F.lds + RING_OFF, g, S, E);
            SEAM(pb); STAMP(pb);
        }
        if (IN(pb + 1)) {
            const int n_attc = last ? 0 : 128, n_g = last ? 256 : 288; const int o_attl = 64, o_attc = o_attl + 1024, o_g = o_attc + n_attc, total = o_g + n_g;
            gu32* head = F.ctl + CW_Q + 64 * l;
            for (;;) {
                if (F.tid == 0) F.MISC[0] = __hip_atomic_fetch_add((unsigned*)head, 1u, RLX_AGENT);
                __syncthreads(); const int unit = (int)F.MISC[0]; __syncthreads();
                if (unit >= total) break;
#if defined(PROBE_UNIT_KIND)
                const unsigned long long tu0 = __builtin_amdgcn_s_memrealtime(); const int ukind = unit < o_attl ? 1 : unit < o_attc ? 2 : unit < o_g ? 3 : 4;
#endif
                if (unit < o_attl) lru_unit(F, l, unit >> 2, unit & 3);
                else if (unit < o_attc) { const int a = unit - o_attl; const int b = a >> 6, kvh = (a >> 5) & 1, qb = (a >> 2) & 7, h = kvh * 4 + (a & 3);
                    const attn_body::bf16* Zb = (const attn_body::bf16*)(ws + WS_Z);
                    attn_body::attn_unit<8>(Zb + (size_t)(b * SEQ + qb * 256) * ZP + C_Q + h * 64, Zb + (size_t)(b * SEQ) * ZP + C_K + kvh * 64, Zb + (size_t)(NLAT + b * CTXL) * ZP + C_K + kvh * 64, 32, 36, (char*)F.ldsg + RING_OFF); }
                else if (unit < o_g) { const int a = unit - o_attc; const int b = a >> 3, h = a & 7;
                    const attn_body::bf16* Zb = (const attn_body::bf16*)(ws + WS_Z); const attn_body::bf16* kc = Zb + (size_t)(NLAT + b * CTXL) * ZP + C_K + (h >> 2) * 64;
                    attn_body::attn_unit<8>(Zb + (size_t)(NLAT + b * CTXL) * ZP + C_Q + h * 64, kc, kc, 4, 4, (char*)F.ldsg + RING_OFF); }
                else gmlp_unit(F, l, unit - o_g);
#if defined(PROBE_UNIT_KIND)
                if (ukind == PROBE_UNIT_KIND && l == PROBE_LAYER) t_unit += __builtin_amdgcn_s_memrealtime() - tu0;
#endif
            }
            SEAM(pb + 1); STAMP(pb + 1);
        }
        if (IN(pb + 2)) {
            const int M3 = last ? NLAT : MROWS;
            pg8::Gemm g{(const bf16*)(ws + WS_Z), (const bf16*)(ws + WS_WO) + (size_t)l * DMODEL * K2, M3, DMODEL, K2, ZP}; pg8::StaticOrder S; S.init(M3, DMODEL, F.G, F.bid);
            pg8::Epi2 E{inptr(0), inptr(2), (float*)(ws + WS_XT), (const float*)(ws + WS_MODS) + (size_t)l * 17 * 3072, l == 0 ? 1 : 0};
            pg8::gemm_phase<pg8::Epi2, pg8::StaticOrder, true, true>(F.lds + RING_OFF, g, S, E);
            SEAM(pb + 2); STAMP(pb + 2);
        }
        if (IN(pb + 3)) { p4_ln(F, l); SEAM(pb + 3); STAMP(pb + 3); }
    }
#if defined(PROBE_UNIT_KIND)
    if (threadIdx.x == 0) { const unsigned long long t0 = __builtin_amdgcn_s_memrealtime(); while (__builtin_amdgcn_s_memrealtime() - t0 < (unsigned long long)PROBE_MULT * t_unit) __builtin_amdgcn_s_sleep(8); }
#endif
    if (PROBE_MASK != 0u && blockIdx.x == 0 && threadIdx.x == 0) { const unsigned long long t0 = __builtin_amdgcn_s_memrealtime(); while (__builtin_amdgcn_s_memrealtime() - t0 < (unsigned long long)PROBE_MULT * t_acc) __builtin_amdgcn_s_sleep(8); }
#undef IN
#undef STAMP
#undef SEAM
}

extern "C" void kernel_launch(void* const* d_in, const int* in_sizes, int n_in, void* d_out, int out_size, void* d_ws, size_t ws_size, hipStream_t stream) {
    static int grid = 0;
    if (grid == 0) {
        if (n_in != 23 || out_size != NLAT * DMODEL || ws_size < WS_END) { fprintf(stderr, "kernel_launch: unexpected shapes (n_in %d out %d ws %zu, need %zu); nothing launched\n", n_in, out_size, ws_size, (size_t)WS_END); grid = -1; return; }
        int dev = 0, cus = 0;
        if (hipGetDevice(&dev) != hipSuccess || hipDeviceGetAttribute(&cus, hipDeviceAttributeMultiprocessorCount, dev) != hipSuccess) { grid = -1; return; }
        if (hipFuncSetAttribute((const void*)mk_fwd, hipFuncAttributeMaxDynamicSharedMemorySize, LDS_BYTES) != hipSuccess) { fprintf(stderr, "kernel_launch: hipFuncSetAttribute failed\n"); grid = -1; return; }
        int per_cu = 0; (void)hipOccupancyMaxActiveBlocksPerMultiprocessor(&per_cu, (const void*)mk_fwd, NWAVES * 64, LDS_BYTES); (void)hipGetLastError();
        grid = cus;
    }
    if (grid < 0) return;
    if (hipMemsetAsync((char*)d_ws + WS_CTL, 0, CTL_ZERO_BYTES, stream) != hipSuccess) return;
    Args a{};
    for (int i = 0; i < 23; ++i) a.in[i] = (const float*)d_in[i];
    a.out = (float*)d_out; a.ws = (unsigned char*)d_ws;
#if MK_PER_PHASE
    for (int p = 0; p < NPHASE; ++p) { a.ph_lo = p; a.ph_hi = p + 1; hipLaunchKernelGGL(mk_fwd, dim3(grid), dim3(NWAVES * 64), LDS_BYTES, stream, a); }
#else
    a.ph_lo = 0; a.ph_hi = NPHASE;
    hipLaunchKernelGGL(mk_fwd, dim3(grid), dim3(NWAVES * 64), LDS_BYTES, stream, a);
#endif
}
```
